# Optimizing an MI355X kernel written in HIP

```python
import math
import jax, jax.numpy as jnp
from jax import lax
import numpy as np

D_MODEL = 1024
BATCH = 8
SEQ = 4096
DEPTH = 4

N_EVEN = (DEPTH + 1) // 2
N_ODD = DEPTH // 2
QBLK = 128
EPS = 1e-6
MASK_VALUE = -1e30

A_WIDTH = D_MODEL // 2
A_HEAD_DIM = 64
A_HEADS = A_WIDTH // (2 * A_HEAD_DIM)
B_WIDTH = D_MODEL - A_WIDTH
POOL_WINDOWS = (2, 4, 8, 16)
B_GROUPS = len(POOL_WINDOWS)
B_GROUP_DIM = B_WIDTH // B_GROUPS
AB_IN = 3 * A_WIDTH + B_WIDTH
C_HEAD_DIM = 64
C_Q_HEADS = D_MODEL // C_HEAD_DIM
C_KV_HEADS = 2
C_GROUP = C_Q_HEADS // C_KV_HEADS
C_WINDOW = 128
C_IN = (C_Q_HEADS + 2 * C_KV_HEADS) * C_HEAD_DIM
D_FF = 2816
CONV_W = 3

kernel_name = "hybrid_diffattn_pool_swa_sink_convffn"


def rms_norm(x, g):
    xf = x.astype(jnp.float32)
    y = xf * lax.rsqrt(jnp.mean(xf * xf, axis=-1, keepdims=True) + EPS)
    return (y * g.astype(jnp.float32)).astype(x.dtype)


def alibi_slopes(n):
    return 2.0 ** (-8.0 * jnp.arange(1, n + 1, dtype=jnp.float32) / n)


def diff_attention(q, k, v, lam, lam_init, sub_g):
    B, S = q.shape[0], q.shape[1]
    nb = S // QBLK
    scale = A_HEAD_DIM ** -0.5
    slopes = alibi_slopes(A_HEADS)
    kf = k.astype(jnp.float32)
    vf = v.astype(jnp.float32)
    key_pos = jnp.arange(S)
    qb = q.reshape(B, nb, QBLK, A_HEADS, 2, A_HEAD_DIM).transpose(1, 0, 2, 3, 4, 5)

    def block(args):
        qi, i = args
        qpos = i * QBLK + jnp.arange(QBLK)
        rel = (qpos[:, None] - key_pos[None, :]).astype(jnp.float32)
        bias = jnp.where(rel[None] >= 0, -slopes[:, None, None] * rel[None], MASK_VALUE)
        s = jnp.einsum('bqhmd,bkhmd->bhmqk', qi.astype(jnp.float32), kf) * scale + bias[None, :, None]
        p = jax.nn.softmax(s, axis=-1)
        attn = p[:, :, 0] - lam * p[:, :, 1]
        return jnp.einsum('bhqk,bkhe->bqhe', attn, vf)

    o = lax.map(block, (qb, jnp.arange(nb)))
    o = o.transpose(1, 0, 2, 3, 4).reshape(B, S, A_HEADS, 2 * A_HEAD_DIM)
    o = rms_norm(o, sub_g) * (1.0 - lam_init)
    return o.reshape(B, S, A_WIDTH)


def pool_mixer(u, w_group, scale):
    B, S = u.shape[0], u.shape[1]
    uf = u.astype(jnp.float32)
    cs = jnp.pad(lax.cumsum(uf, axis=1), ((0, 0), (1, 0), (0, 0)))
    pos = jnp.arange(S)
    outs = []
    for g, w in enumerate(POOL_WINDOWS):
        lo_c, hi_c = g * B_GROUP_DIM, (g + 1) * B_GROUP_DIM
        csg = cs[:, :, lo_c:hi_c]
        start = jnp.maximum(pos + 1 - w, 0)
        win_sum = csg[:, 1:] - csg[:, start]
        cnt = jnp.minimum(pos + 1, w).astype(jnp.float32)
        outs.append(win_sum / cnt[None, :, None] - uf[:, :, lo_c:hi_c])
    pooled = jnp.stack(outs, axis=2)
    mixed = jnp.einsum('bsgc,gcd->bsgd', pooled, w_group.astype(jnp.float32))
    return mixed.reshape(B, S, B_WIDTH) * scale.astype(jnp.float32)


def sliding_window_attention(q, k, v, sinks):
    B, S = q.shape[0], q.shape[1]
    nb = S // QBLK
    scale = C_HEAD_DIM ** -0.5
    slopes = alibi_slopes(C_Q_HEADS).reshape(C_KV_HEADS, C_GROUP)
    sink = sinks.astype(jnp.float32).reshape(C_KV_HEADS, C_GROUP)[None, :, :, None, None]
    pad = ((0, 0), (QBLK, 0), (0, 0), (0, 0))
    kp = jnp.pad(k.astype(jnp.float32), pad)
    vp = jnp.pad(v.astype(jnp.float32), pad)
    qb = q.reshape(B, nb, QBLK, C_KV_HEADS, C_GROUP, C_HEAD_DIM).transpose(1, 0, 2, 3, 4, 5)
    a_idx = jnp.arange(QBLK)[:, None]
    j_idx = jnp.arange(2 * QBLK)[None, :]
    rel = QBLK + a_idx - j_idx
    alibi = -slopes[:, :, None, None] * rel.astype(jnp.float32)

    def block(args):
        qi, i = args
        kb = lax.dynamic_slice_in_dim(kp, i * QBLK, 2 * QBLK, axis=1)
        vb = lax.dynamic_slice_in_dim(vp, i * QBLK, 2 * QBLK, axis=1)
        key_pos = (i - 1) * QBLK + j_idx
        valid = (rel >= 0) & (rel < C_WINDOW) & (key_pos >= 0)
        bias = jnp.where(valid, alibi, MASK_VALUE)
        s = jnp.einsum('bqhgd,bkhd->bhgqk', qi.astype(jnp.float32), kb) * scale + bias
        m = jnp.maximum(jnp.max(s, axis=-1, keepdims=True), sink)
        p = jnp.exp(s - m)
        denom = jnp.sum(p, axis=-1, keepdims=True) + jnp.exp(sink - m)
        return jnp.einsum('bhgqk,bkhd->bqhgd', p / denom, vb)

    o = lax.map(block, (qb, jnp.arange(nb)))
    return o.transpose(1, 0, 2, 3, 4, 5).reshape(B, S, C_Q_HEADS * C_HEAD_DIM)


def diff_pool_layer(x, layer_idx, norm_g, w_in, q_g, k_g, lam_p, sub_g, w_group, pool_scale, w_out):
    B, S = x.shape[0], x.shape[1]
    proj = rms_norm(x, norm_g) @ w_in
    q, k, v, u = jnp.split(proj, [A_WIDTH, 2 * A_WIDTH, 3 * A_WIDTH], axis=-1)
    q = rms_norm(q.reshape(B, S, A_HEADS, 2, A_HEAD_DIM), q_g)
    k = rms_norm(k.reshape(B, S, A_HEADS, 2, A_HEAD_DIM), k_g)
    v = v.reshape(B, S, A_HEADS, 2 * A_HEAD_DIM)
    lam_init = 0.8 - 0.6 * math.exp(-0.3 * layer_idx)
    lp = lam_p.astype(jnp.float32)
    lam = jnp.exp(jnp.sum(lp[0] * lp[1])) - jnp.exp(jnp.sum(lp[2] * lp[3])) + lam_init
    a_out = diff_attention(q, k, v, lam, lam_init, sub_g)
    b_out = pool_mixer(u, w_group, pool_scale)
    mix = jnp.concatenate([a_out.astype(jnp.float32), b_out], axis=-1).astype(x.dtype)
    return x + mix @ w_out


def swa_layer(x, norm_g, w_in, q_g, k_g, sinks, w_out):
    B, S = x.shape[0], x.shape[1]
    proj = rms_norm(x, norm_g) @ w_in
    kv_w = C_KV_HEADS * C_HEAD_DIM
    q, k, v = jnp.split(proj, [C_Q_HEADS * C_HEAD_DIM, C_Q_HEADS * C_HEAD_DIM + kv_w], axis=-1)
    q = rms_norm(q.reshape(B, S, C_KV_HEADS, C_GROUP, C_HEAD_DIM), q_g)
    k = rms_norm(k.reshape(B, S, C_KV_HEADS, C_HEAD_DIM), k_g)
    v = v.reshape(B, S, C_KV_HEADS, C_HEAD_DIM)
    o = sliding_window_attention(q, k, v, sinks).astype(x.dtype)
    return x + o @ w_out


def conv_glu_ffn(x, norm_g, w_up, conv_w, conv_b, w_down):
    S = x.shape[1]
    h = rms_norm(x, norm_g) @ w_up
    hp = jnp.pad(h, ((0, 0), (CONV_W - 1, 0), (0, 0)))
    c = conv_b
    for j in range(CONV_W):
        c = c + conv_w[j] * hp[:, j:j + S]
    gate, up = jnp.split(c, 2, axis=-1)
    return x + (jax.nn.silu(gate) * up) @ w_down


def setup_inputs(seed: int = 0) -> dict:
    key = jax.random.key(seed)
    ks = jax.random.split(key, 24)
    f32 = jnp.float32
    nrm = lambda k, shape, s: jax.random.normal(k, shape, f32) * s
    return {
        "x": nrm(ks[0], (BATCH, SEQ, D_MODEL), 1.0),
        "ab_norm": 1.0 + nrm(ks[1], (N_EVEN, D_MODEL), 0.02),
        "ab_w_in": nrm(ks[2], (N_EVEN, D_MODEL, AB_IN), D_MODEL ** -0.5),
        "a_q_norm": 1.0 + nrm(ks[3], (N_EVEN, A_HEAD_DIM), 0.02),
        "a_k_norm": 1.0 + nrm(ks[4], (N_EVEN, A_HEAD_DIM), 0.02),
        "a_lambda": nrm(ks[5], (N_EVEN, 4, A_HEAD_DIM), 0.1),
        "a_sub_norm": 1.0 + nrm(ks[6], (N_EVEN, 2 * A_HEAD_DIM), 0.02),
        "b_w_group": nrm(ks[7], (N_EVEN, B_GROUPS, B_GROUP_DIM, B_GROUP_DIM), B_GROUP_DIM ** -0.5),
        "b_scale": 1.0 + nrm(ks[8], (N_EVEN, B_WIDTH), 0.1),
        "ab_w_out": nrm(ks[9], (N_EVEN, A_WIDTH + B_WIDTH, D_MODEL), (A_WIDTH + B_WIDTH) ** -0.5),
        "c_norm": 1.0 + nrm(ks[10], (N_ODD, D_MODEL), 0.02),
        "c_w_in": nrm(ks[11], (N_ODD, D_MODEL, C_IN), D_MODEL ** -0.5),
        "c_q_norm": 1.0 + nrm(ks[12], (N_ODD, C_HEAD_DIM), 0.02),
        "c_k_norm": 1.0 + nrm(ks[13], (N_ODD, C_HEAD_DIM), 0.02),
        "c_sinks": nrm(ks[14], (N_ODD, C_Q_HEADS), 0.5),
        "c_w_out": nrm(ks[15], (N_ODD, C_Q_HEADS * C_HEAD_DIM, D_MODEL), (C_Q_HEADS * C_HEAD_DIM) ** -0.5),
        "f_norm": 1.0 + nrm(ks[16], (DEPTH, D_MODEL), 0.02),
        "f_w_up": nrm(ks[17], (DEPTH, D_MODEL, 2 * D_FF), D_MODEL ** -0.5),
        "f_conv": nrm(ks[18], (DEPTH, CONV_W, 2 * D_FF), CONV_W ** -0.5),
        "f_conv_b": nrm(ks[19], (DEPTH, 2 * D_FF), 0.02),
        "f_w_down": nrm(ks[20], (DEPTH, D_FF, D_MODEL), D_FF ** -0.5),
    }


def reference(x, ab_norm, ab_w_in, a_q_norm, a_k_norm, a_lambda, a_sub_norm, b_w_group, b_scale,
              ab_w_out, c_norm, c_w_in, c_q_norm, c_k_norm, c_sinks, c_w_out,
              f_norm, f_w_up, f_conv, f_conv_b, f_w_down):
    for layer in range(DEPTH):
        if layer % 2 == 0:
            e = layer // 2
            x = diff_pool_layer(x, layer, ab_norm[e], ab_w_in[e], a_q_norm[e], a_k_norm[e],
                                a_lambda[e], a_sub_norm[e], b_w_group[e], b_scale[e], ab_w_out[e])
        else:
            o = layer // 2
            x = swa_layer(x, c_norm[o], c_w_in[o], c_q_norm[o], c_k_norm[o], c_sinks[o], c_w_out[o])
        x = conv_glu_ffn(x, f_norm[layer], f_w_up[layer], f_conv[layer], f_conv_b[layer], f_w_down[layer])
    return x
```

```cpp
#include <hip/hip_runtime.h>
#include <hip/hip_cooperative_groups.h>
#include <cstdio>
#include <cstdint>
namespace cg = cooperative_groups;

#define LAS __attribute__((address_space(3)))
#define DI __device__ __forceinline__
typedef unsigned short bf16_t;
typedef short bf16x8 __attribute__((ext_vector_type(8)));
typedef short s16x4 __attribute__((ext_vector_type(4)));
typedef float f32x4 __attribute__((ext_vector_type(4)));
typedef float f32x2 __attribute__((ext_vector_type(2)));
typedef float f32x16 __attribute__((ext_vector_type(16)));
typedef unsigned u32x4 __attribute__((ext_vector_type(4)));
typedef unsigned u32x2 __attribute__((ext_vector_type(2)));
typedef __bf16 bf16x2_t __attribute__((ext_vector_type(2)));

constexpr int DM = 1024, BATCH = 8, SEQ = 4096, MTOK = BATCH * SEQ, DEPTH = 4;
constexpr int AB_IN = 2048, C_IN = 1280, DFF = 2816, NUP = 5632;
constexpr float EPS = 1e-6f;
constexpr float LOG2E = 1.4426950408889634f;
constexpr float QSCALE = 0.125f * LOG2E;

constexpr size_t MiB = 1u << 20;
constexpr size_t WS_W_ABIN = 0, WS_W_ABOUT = 8 * MiB, WS_W_CIN = 12 * MiB, WS_W_COUT = 17 * MiB, WS_W_UP = 21 * MiB, WS_W_DOWN = 65 * MiB;
constexpr size_t WS_ROWSS = 390 * MiB;
constexpr size_t WS_HB = 88 * MiB;
constexpr size_t WS_XB = 132 * MiB;
constexpr size_t WS_QKV = 196 * MiB;
constexpr size_t WS_MIX = 324 * MiB;
constexpr size_t WS_ACT = 196 * MiB;
constexpr size_t WS_CTL = 388 * MiB;
constexpr size_t WS_END = 406 * MiB;

DI unsigned cvtpk(float lo, float hi) { f32x2 v = {lo, hi}; bf16x2_t b = __builtin_convertvector(v, bf16x2_t); return __builtin_bit_cast(unsigned, b); }
DI float bf_lo(unsigned u) { return __uint_as_float(u << 16); }
DI float bf_hi(unsigned u) { return __uint_as_float(u & 0xffff0000u); }
DI float wave_sum(float v) {
#pragma unroll
    for (int o = 1; o < 64; o <<= 1) v += __shfl_xor(v, o);
    return v;
}
DI float xhalf_max(float v) { auto rr = __builtin_amdgcn_permlane32_swap(__float_as_uint(v), __float_as_uint(v), false, false); return fmaxf(__uint_as_float(rr[0]), __uint_as_float(rr[1])); }
DI float xhalf_sum(float v) { auto rr = __builtin_amdgcn_permlane32_swap(__float_as_uint(v), __float_as_uint(v), false, false); return __uint_as_float(rr[0]) + __uint_as_float(rr[1]); }

namespace pg8 {
constexpr int BM = 256, BK = 64, HALF = 128, HTB = HALF * BK * 2, STAGE_BYTES = 8 * HTB, NXCD = 8, WGM = 4;
__host__ __device__ __forceinline__ int lds_byte(int r, int c) { const int st = (r >> 4) * 2 + (c >> 5), rr = r & 15, cc = c & 31, ob = rr * 64 + cc * 2; return st * 1024 + (ob ^ (((ob >> 9) & 1) << 5)); }
__host__ __device__ __forceinline__ void stage_rc(int b, int& R, int& C) { const int st = b / 1024, sb = b % 1024, swz = sb ^ (((sb >> 9) & 1) << 5); R = (st >> 1) * 16 + swz / 64; C = (st & 1) * 32 + (swz % 64) / 2; }
__host__ __device__ __forceinline__ int perm32(int rho) { const int n = rho >> 4, i = rho & 15; return 8 * (i >> 2) + 4 * n + (i & 3); }
struct Unit { int pm, pn; };
struct Gemm { const bf16_t* A; const bf16_t* Bt; int M, N, K; };
struct StaticOrder {
    int nM, nN, nwg, G, c;
    __device__ void init(int M, int N, int G_, int c_) { nM = M / BM; nN = N / BM; nwg = nM * nN; G = G_; c = c_; }
    __device__ bool next(int i, Unit& u) const {
        const long L = (long)i * G + c; if (L >= nwg) return false;
        int wgid = (int)L; { const int q = nwg / NXCD, r = nwg % NXCD, xcd = wgid % NXCD, off = wgid / NXCD; wgid = (xcd < r ? xcd * (q + 1) : r * (q + 1) + (xcd - r) * q) + off; }
        const int nig = WGM * nN, gid = wgid / nig, fm = gid * WGM, gsz = (nM - fm) < WGM ? (nM - fm) : WGM;
        u.pm = fm + ((wgid % nig) % gsz); u.pn = (wgid % nig) / gsz; return true;
    }
};
template <class Epi>
__device__ __forceinline__ void gemm_phase(LAS unsigned char* lds, const Gemm g, const StaticOrder& S, const Epi& E) {
    int tid = threadIdx.x; asm volatile("" : "+v"(tid));
    const int wid = __builtin_amdgcn_readfirstlane(tid >> 6), lane = tid & 63, wr = wid >> 2, wc = wid & 3, fr = lane & 15, fq = lane >> 4;
    const int K = g.K, nt = K / BK;
    unsigned voffA[2], voffB[2];
#pragma unroll
    for (int i = 0; i < 2; ++i) { int R, C; stage_rc(tid * 16 + i * 8192, R, C); const int Rb = (R & ~31) + perm32(R & 31);
        voffA[i] = (unsigned)(R * K + C) * 2u; voffB[i] = (unsigned)(Rb * K + C) * 2u; }
    const size_t kstep = (size_t)(BK * 2);
    const size_t hstep = (size_t)HALF * K * 2;
    const size_t tstep = 2 * hstep;
    const unsigned ldsw = (unsigned)wid * 1024u;
    const int aoff = lds_byte(wr * 64 + fr, fq * 8), boff = lds_byte(wc * 32 + fr, fq * 8);
#define PG8_SA(b, h) (((b) * 2 + (h)) * HTB)
#define PG8_SB(b, h) ((4 + (b) * 2 + (h)) * HTB)
#define PG8_STAGE(bufoff, gbase, voff) do { _Pragma("unroll") for (int _i = 0; _i < 2; ++_i) \
        __builtin_amdgcn_global_load_lds((const unsigned*)((const char*)(gbase) + (voff)[_i]), (LAS unsigned*)(lds + (bufoff) + ldsw + _i * 8192), 16, 0, 0); } while (0)
#define PG8_LDA(dst, b, h) do { _Pragma("unroll") for (int m = 0; m < 4; ++m) _Pragma("unroll") for (int k = 0; k < 2; ++k) dst[m][k] = *(const LAS bf16x8*)(lds + PG8_SA(b, h) + aoff + m * 2048 + k * 1024); } while (0)
#define PG8_LDB(dst, b, h) do { _Pragma("unroll") for (int n = 0; n < 2; ++n) _Pragma("unroll") for (int k = 0; k < 2; ++k) dst[n][k] = *(const LAS bf16x8*)(lds + PG8_SB(b, h) + boff + n * 2048 + k * 1024); } while (0)
#define PG8_MMA(ai, bj, At, Bt) do { __builtin_amdgcn_s_setprio(1); _Pragma("unroll") for (int m = 0; m < 4; ++m) _Pragma("unroll") for (int n = 0; n < 2; ++n) _Pragma("unroll") for (int k = 0; k < 2; ++k) \
        acc[ai][bj][m][n] = __builtin_amdgcn_mfma_f32_16x16x32_bf16(Bt[n][k], At[m][k], acc[ai][bj][m][n], 0, 0, 0); __builtin_amdgcn_s_setprio(0); } while (0)
#define PG8_WAIT_V(n) asm volatile("s_waitcnt vmcnt(" #n ")" ::: "memory")
#define PG8_WAIT_L(n) asm volatile("s_waitcnt lgkmcnt(" #n ")" ::: "memory")
#define PG8_BAR __builtin_amdgcn_s_barrier()
#define PG8_SCHED __builtin_amdgcn_sched_barrier(0)
    Unit cur, nxt; int ui = 0;
    if (!S.next(0, cur)) return;
    f32x4 acc[2][2][4][2];
#pragma unroll
    for (int a = 0; a < 2; ++a)
#pragma unroll
        for (int b = 0; b < 2; ++b)
#pragma unroll
            for (int m = 0; m < 4; ++m)
#pragma unroll
                for (int n = 0; n < 2; ++n) acc[a][b][m][n] = (f32x4){0.f, 0.f, 0.f, 0.f};
    bf16x8 At[4][2], B0[2][2], B1[2][2];
    const char* cA = (const char*)g.A + (size_t)cur.pm * tstep; const char* cB = (const char*)g.Bt + (size_t)cur.pn * tstep;
    PG8_STAGE(PG8_SB(0, 0), cB, voffB); PG8_STAGE(PG8_SB(0, 1), cB + hstep, voffB); PG8_STAGE(PG8_SA(0, 0), cA, voffA); PG8_STAGE(PG8_SA(0, 1), cA + hstep, voffA);
    if (wr == 1) PG8_BAR;
    PG8_WAIT_V(2); PG8_BAR;
    PG8_STAGE(PG8_SB(1, 0), cB + kstep, voffB); PG8_STAGE(PG8_SA(1, 0), cA + kstep, voffA); PG8_STAGE(PG8_SB(1, 1), cB + hstep + kstep, voffB);
    PG8_WAIT_V(6); PG8_BAR;
    for (;;) {
        const bool has_next = S.next(ui + 1, nxt);
        const char* nA = has_next ? (const char*)g.A + (size_t)nxt.pm * tstep : cA; const char* nB = has_next ? (const char*)g.Bt + (size_t)nxt.pn * tstep : cB;
        for (int t = 0; t < nt; t += 2) {
            const bool last = (t == nt - 2);
            const char* a1 = cA + (size_t)(t + 1) * kstep;
            const char* a2 = last ? nA : cA + (size_t)(t + 2) * kstep; const char* b2 = last ? nB : cB + (size_t)(t + 2) * kstep;
            const char* a3 = a2 + kstep; const char* b3 = b2 + kstep;
            PG8_LDB(B0, 0, 0); PG8_LDB(B1, 0, 1); PG8_SCHED; PG8_LDA(At, 0, 0); PG8_STAGE(PG8_SA(1, 1), a1 + hstep, voffA);
            PG8_WAIT_V(8); PG8_WAIT_L(0); PG8_BAR; PG8_MMA(0, 0, At, B0); PG8_MMA(0, 1, At, B1); PG8_BAR; PG8_SCHED;
            PG8_LDA(At, 0, 1); PG8_STAGE(PG8_SB(0, 0), b2, voffB); PG8_STAGE(PG8_SB(0, 1), b2 + hstep, voffB); PG8_STAGE(PG8_SA(0, 0), a2, voffA);
            PG8_WAIT_V(8); PG8_WAIT_L(0); PG8_BAR; PG8_MMA(1, 0, At, B0); PG8_MMA(1, 1, At, B1); PG8_BAR; PG8_SCHED;
            PG8_LDB(B0, 1, 0); PG8_LDB(B1, 1, 1); PG8_SCHED; PG8_LDA(At, 1, 0); PG8_STAGE(PG8_SA(0, 1), a2 + hstep, voffA);
            PG8_WAIT_V(8); PG8_WAIT_L(0); PG8_BAR; PG8_MMA(0, 0, At, B0); PG8_MMA(0, 1, At, B1); PG8_BAR; PG8_SCHED;
            PG8_LDA(At, 1, 1); PG8_STAGE(PG8_SB(1, 0), b3, voffB); PG8_STAGE(PG8_SB(1, 1), b3 + hstep, voffB); PG8_STAGE(PG8_SA(1, 0), a3, voffA);
            PG8_WAIT_V(8); PG8_WAIT_L(0); PG8_BAR; PG8_MMA(1, 0, At, B0); PG8_MMA(1, 1, At, B1); PG8_BAR; PG8_SCHED;
        }
        if (wr == 0) PG8_BAR;
        E(acc, cur, wr, wc, fr, fq);
        if (!has_next) break;
#pragma unroll
        for (int a = 0; a < 2; ++a)
#pragma unroll
            for (int b = 0; b < 2; ++b)
#pragma unroll
                for (int m = 0; m < 4; ++m)
#pragma unroll
                    for (int n = 0; n < 2; ++n) acc[a][b][m][n] = (f32x4){0.f, 0.f, 0.f, 0.f};
        cur = nxt; cA = nA; cB = nB; ++ui;
        if (wr == 1) PG8_BAR;
    }
    PG8_WAIT_V(0);
    PG8_BAR;
#undef PG8_SA
#undef PG8_SB
#undef PG8_STAGE
#undef PG8_LDA
#undef PG8_LDB
#undef PG8_MMA
#undef PG8_WAIT_V
#undef PG8_WAIT_L
#undef PG8_BAR
#undef PG8_SCHED
}
}

constexpr int RTAB_OFF = 131072;
DI void rstd_table(const float* slots, LAS float* rtab, int pm, int wr, int wc, int fr, int fq, const float* cw = nullptr, const float* cb = nullptr, int pn = 0) {
    const int tid = (wr * 4 + wc) * 64 + fq * 16 + fr, rl = tid >> 1, hf = tid & 1;
    const f32x4* p = (const f32x4*)(slots + (size_t)(pm * 256 + rl) * 16 + hf * 8);
    const f32x4 a = p[0], b = p[1];
    if (cw) {
        float t[2];
#pragma unroll
        for (int k = 0; k < 2; ++k) { const int idx = tid + 512 * k, j = idx >> 8, x = idx & 255, col = (x >> 7) * DFF + 128 * pn + (x & 127); t[k] = (j < 3) ? cw[j * NUP + col] : cb[col]; }
        rtab[256 + tid] = t[0]; rtab[256 + 512 + tid] = t[1];
    }
    float ss = ((a[0] + a[1]) + (a[2] + a[3])) + ((b[0] + b[1]) + (b[2] + b[3]));
    ss += __shfl_xor(ss, 1);
    if (!hf) rtab[rl] = rsqrtf(ss * (1.0f / 1024.0f) + EPS);
    asm volatile("s_waitcnt lgkmcnt(0)" ::: "memory"); __builtin_amdgcn_s_barrier(); asm volatile("" ::: "memory");
}
struct EpiQKV {
    const float* rowss; const float* qg; const float* kg; bf16_t* out; int ld, nq, nqk; LAS float* rtab;
    DI void operator()(f32x4 (&acc)[2][2][4][2], const pg8::Unit& u, int wr, int wc, int fr, int fq) const {
        rstd_table(rowss, rtab, u.pm, wr, wc, fr, fq);
        const int grp = 4 * u.pn + wc;
        const int row0 = u.pm * 256 + wr * 64 + fr;
        const bool donorm = grp < nqk, isq = grp < nq;
        f32x4 g[2][2];
#pragma unroll
        for (int bj = 0; bj < 2; ++bj)
#pragma unroll
            for (int n = 0; n < 2; ++n) {
                f32x4 t = (f32x4){1.f, 1.f, 1.f, 1.f};
                if (donorm) { t = *(const f32x4*)((isq ? qg : kg) + 32 * bj + 8 * fq + 4 * n); if (isq) t = t * QSCALE; }
                g[bj][n] = t;
            }
#pragma unroll
        for (int ai = 0; ai < 2; ++ai)
#pragma unroll
            for (int m = 0; m < 4; ++m) {
                const int row = row0 + ai * 128 + m * 16;
                const float rstd = rtab[ai * 128 + wr * 64 + m * 16 + fr];
                f32x4 v[2][2]; float ss = 0.f;
#pragma unroll
                for (int bj = 0; bj < 2; ++bj)
#pragma unroll
                    for (int n = 0; n < 2; ++n) { v[bj][n] = acc[ai][bj][m][n] * rstd; const f32x4 x = v[bj][n]; ss += (x[0] * x[0] + x[1] * x[1]) + (x[2] * x[2] + x[3] * x[3]); }
                float rn = 1.f;
                if (donorm) { ss += __shfl_xor(ss, 16); ss += __shfl_xor(ss, 32); rn = rsqrtf(ss * (1.0f / 64.0f) + EPS); }
#pragma unroll
                for (int bj = 0; bj < 2; ++bj) {
                    const f32x4 o0 = v[bj][0] * rn * g[bj][0], o1 = v[bj][1] * rn * g[bj][1];
                    u32x4 w; w.x = cvtpk(o0[0], o0[1]); w.y = cvtpk(o0[2], o0[3]); w.z = cvtpk(o1[0], o1[1]); w.w = cvtpk(o1[2], o1[3]);
                    *(u32x4*)(out + (size_t)row * ld + 64 * grp + 32 * bj + 8 * fq) = w;
                }
            }
    }
};
struct EpiRes {
    const float* basef; bf16_t* xb; float* outf; float* rowss_out;
    DI void operator()(f32x4 (&acc)[2][2][4][2], const pg8::Unit& u, int wr, int wc, int fr, int fq) const {
        const int col0 = u.pn * 256 + wc * 32 + 8 * fq;
        const int row0 = u.pm * 256 + wr * 64 + fr;
        u32x4 bw[2][4][2];
        if (!basef) {
#pragma unroll
            for (int ai = 0; ai < 2; ++ai)
#pragma unroll
                for (int m = 0; m < 4; ++m)
#pragma unroll
                    for (int bj = 0; bj < 2; ++bj) bw[ai][m][bj] = *(const u32x4*)(xb + (size_t)(row0 + ai * 128 + m * 16) * DM + col0 + bj * 128);
            __builtin_amdgcn_sched_barrier(0);
        }
#pragma unroll
        for (int ai = 0; ai < 2; ++ai)
#pragma unroll
            for (int m = 0; m < 4; ++m) {
                const int row = row0 + ai * 128 + m * 16; float ss = 0.f;
#pragma unroll
                for (int bj = 0; bj < 2; ++bj) {
                    const size_t off = (size_t)row * DM + col0 + bj * 128;
                    f32x4 b0, b1;
                    if (basef) { b0 = *(const f32x4*)(basef + off); b1 = *(const f32x4*)(basef + off + 4); }
                    else { const u32x4 w = bw[ai][m][bj]; b0 = (f32x4){bf_lo(w.x), bf_hi(w.x), bf_lo(w.y), bf_hi(w.y)}; b1 = (f32x4){bf_lo(w.z), bf_hi(w.z), bf_lo(w.w), bf_hi(w.w)}; }
                    const f32x4 v0 = acc[ai][bj][m][0] + b0, v1 = acc[ai][bj][m][1] + b1;
                    if (outf) { *(f32x4*)(outf + off) = v0; *(f32x4*)(outf + off + 4) = v1; }
                    else { u32x4 w; w.x = cvtpk(v0[0], v0[1]); w.y = cvtpk(v0[2], v0[3]); w.z = cvtpk(v1[0], v1[1]); w.w = cvtpk(v1[2], v1[3]); *(u32x4*)(xb + off) = w; }
                    ss += (v0[0] * v0[0] + v0[1] * v0[1]) + (v0[2] * v0[2] + v0[3] * v0[3]) + (v1[0] * v1[0] + v1[1] * v1[1]) + (v1[2] * v1[2] + v1[3] * v1[3]);
                }
                if (rowss_out) { ss += __shfl_xor(ss, 16); ss += __shfl_xor(ss, 32); if (fq == 0) rowss_out[(size_t)row * 16 + u.pn * 4 + wc] = ss; }
            }
    }
};
template <int N> DI float shift_rows(float cur, float prev) {
    const int t = __builtin_amdgcn_mov_dpp(__float_as_int(prev), 0x120 + N, 0xf, 0xf, true);
    const int r = __builtin_amdgcn_update_dpp(t, __float_as_int(cur), 0x110 + N, 0xf, 0xf, false);
    return __int_as_float(r);
}
template <int N> DI float shift_rows0(float cur) {
    return __int_as_float(__builtin_amdgcn_update_dpp(0, __float_as_int(cur), 0x110 + N, 0xf, 0xf, true));
}
struct EpiUp {
    const float* rowss; const float* cw; const float* cb; bf16_t* act; float* hb; LAS float* rtab;
    DI void operator()(f32x4 (&acc)[2][2][4][2], const pg8::Unit& u, int wr, int wc, int fr, int fq) const {
        rstd_table(rowss, rtab, u.pm, wr, wc, fr, fq, cw, cb, u.pn);
        const int ff0 = 128 * u.pn + 32 * wc + 8 * fq;
        const int row0 = u.pm * 256 + wr * 64 + fr;
#pragma unroll
        for (int ai = 0; ai < 2; ++ai)
#pragma unroll
            for (int m = 0; m < 4; ++m) {
                const float rstd = rtab[ai * 128 + wr * 64 + m * 16 + fr];
#pragma unroll
                for (int bj = 0; bj < 2; ++bj)
#pragma unroll
                    for (int n = 0; n < 2; ++n) acc[ai][bj][m][n] = acc[ai][bj][m][n] * rstd;
            }
#pragma unroll
        for (int n = 0; n < 2; ++n) {
            const int colg = ff0 + 4 * n, colu = DFF + colg;
            const LAS float* ct = rtab + 256 + 32 * wc + 8 * fq + 4 * n;
            const f32x4 wg0 = *(const LAS f32x4*)(ct), wg1 = *(const LAS f32x4*)(ct + 256), wg2 = *(const LAS f32x4*)(ct + 512), bg = *(const LAS f32x4*)(ct + 768);
            const f32x4 wu0 = *(const LAS f32x4*)(ct + 128), wu1 = *(const LAS f32x4*)(ct + 384), wu2 = *(const LAS f32x4*)(ct + 640), bu = *(const LAS f32x4*)(ct + 896);
#pragma unroll
            for (int ai = 0; ai < 2; ++ai) {
                const int seg = u.pm * 4 + ai * 2 + wr;
#pragma unroll
                for (int m = 0; m < 4; ++m) {
                    const int row = row0 + ai * 128 + m * 16;
                    const f32x4 cg = acc[ai][0][m][n], cu = acc[ai][1][m][n];
                    f32x4 pg = (f32x4){0.f, 0.f, 0.f, 0.f}, pu = pg;
                    if (m > 0) { pg = acc[ai][0][m - 1][n]; pu = acc[ai][1][m - 1][n]; }
                    float a[4];
#pragma unroll
                    for (int i = 0; i < 4; ++i) {
                        float g1, g2, u1, u2;
                        if (m > 0) { g1 = shift_rows<1>(cg[i], pg[i]); g2 = shift_rows<2>(cg[i], pg[i]); u1 = shift_rows<1>(cu[i], pu[i]); u2 = shift_rows<2>(cu[i], pu[i]); }
                        else { g1 = shift_rows0<1>(cg[i]); g2 = shift_rows0<2>(cg[i]); u1 = shift_rows0<1>(cu[i]); u2 = shift_rows0<2>(cu[i]); }
                        const float gate = bg[i] + wg0[i] * g2 + wg1[i] * g1 + wg2[i] * cg[i];
                        const float upv = bu[i] + wu0[i] * u2 + wu1[i] * u1 + wu2[i] * cu[i];
                        a[i] = gate * __builtin_amdgcn_rcpf(1.0f + __builtin_amdgcn_exp2f(-gate * LOG2E)) * upv;
                    }
                    u32x2 w; w.x = cvtpk(a[0], a[1]); w.y = cvtpk(a[2], a[3]);
                    *(u32x2*)(act + (size_t)row * DFF + colg) = w;
                    if (m == 0 && fr < 2) { float* p = hb + (size_t)(seg * 4 + fr) * NUP; *(f32x4*)(p + colg) = cg; *(f32x4*)(p + colu) = cu; }
                    if (m == 3 && fr >= 14) { float* p = hb + (size_t)(seg * 4 + 2 + fr - 14) * NUP; *(f32x4*)(p + colg) = cg; *(f32x4*)(p + colu) = cu; }
                }
            }
        }
    }
};

#define MFMA32(a, b, c) __builtin_amdgcn_mfma_f32_32x32x16_bf16((a), (b), (c), 0, 0, 0)
typedef short v4i16_t __attribute__((ext_vector_type(4)));
DI s16x4 vtr(LAS const char* p) { return __builtin_bit_cast(s16x4, __builtin_amdgcn_ds_read_tr16_b64_v4i16((LAS v4i16_t*)p)); }
#define CROWC(i) (((i) & 3) + 8 * ((i) >> 2))

template <int C0, int NC, int NT, int KP>
DI void qk_multi(f32x16 (&S)[NT], LAS const char* krow  , const bf16x8 (&qf)[4], float slope2, int dt0, int hh, float mref) {
    bf16x8 kf[NC][4];
#pragma unroll
    for (int c = 0; c < NC; ++c)
#pragma unroll
        for (int st = 0; st < 4; ++st) kf[c][st] = *(const LAS bf16x8*)(krow + (C0 + c) * 32 * KP + st * 32);
    __builtin_amdgcn_sched_barrier(0);
#pragma unroll
    for (int c = 0; c < NC; ++c) {
        const float base2 = slope2 * (float)(4 * hh - (dt0 - 32 * (C0 + c))) - mref;
#pragma unroll
        for (int i = 0; i < 16; ++i) S[C0 + c][i] = fmaf(slope2, (float)CROWC(i), base2);
    }
    __builtin_amdgcn_s_setprio(1);
#pragma unroll
    for (int st = 0; st < 4; ++st)
#pragma unroll
        for (int c = 0; c < NC; ++c) S[C0 + c] = MFMA32(kf[c][st], qf[st], S[C0 + c]);
    __builtin_amdgcn_s_setprio(0);
}
template <int WIN> DI void mask_chunk(f32x16& S, int dt0, int hh, int lo) {
    const int dh = dt0 - 4 * hh, lo2 = lo - 4 * hh;
#pragma unroll
    for (int i = 0; i < 16; ++i) { const int rel = dh - CROWC(i); if (rel < 0 || rel >= WIN || CROWC(i) < lo2) S[i] = -INFINITY; }
}
constexpr float SM_THR = 8.0f;
template <int NH, int NDB, int VP, bool FIXED_REF = false>
DI void softmax_pv(f32x16 (&S)[NH], float& m, float& l, f32x16 (&O)[NDB], LAS const char* vrow) {
    constexpr int NS = 2 * NH;
    s16x4 vlo[2][NDB], vhi[2][NDB];
#define SPV_LOADV(k) do { _Pragma("unroll") for (int db = 0; db < NDB; ++db) { vlo[(k) & 1][db] = vtr(vrow + (16 * (k)) * VP + 64 * db); vhi[(k) & 1][db] = vtr(vrow + (16 * (k) + 8) * VP + 64 * db); } } while (0)
    SPV_LOADV(0);
    float mx = -INFINITY;
    if (!FIXED_REF) {
#pragma unroll
        for (int h = 0; h < NH; ++h)
#pragma unroll
            for (int i = 0; i < 16; i += 2) mx = fmaxf(fmaxf(mx, S[h][i]), S[h][i + 1]);
        mx = xhalf_max(mx);
    }
    if (!FIXED_REF && __any(mx > SM_THR)) {
        const float dl = fmaxf(mx, 0.f), f = __builtin_amdgcn_exp2f(-dl); m += dl; l *= f;
#pragma unroll
        for (int h = 0; h < NH; ++h)
#pragma unroll
            for (int i = 0; i < 16; ++i) S[h][i] -= dl;
#pragma unroll
        for (int db = 0; db < NDB; ++db) O[db] = O[db] * f;
    }
    float rs0 = 0.f, rs1 = 0.f;
#pragma unroll
    for (int h = 0; h < NH; ++h)
#pragma unroll
        for (int i = 0; i < 16; i += 2) { S[h][i] = __builtin_amdgcn_exp2f(S[h][i]); S[h][i + 1] = __builtin_amdgcn_exp2f(S[h][i + 1]); rs0 += S[h][i]; rs1 += S[h][i + 1]; }
    l += rs0 + rs1;
#pragma unroll
    for (int k = 0; k < NS; ++k) {
        const int h = k >> 1, s = k & 1;
        if (k + 1 < NS) SPV_LOADV(k + 1);
        u32x4 pw; pw.x = cvtpk(S[h][8 * s], S[h][8 * s + 1]); pw.y = cvtpk(S[h][8 * s + 2], S[h][8 * s + 3]); pw.z = cvtpk(S[h][8 * s + 4], S[h][8 * s + 5]); pw.w = cvtpk(S[h][8 * s + 6], S[h][8 * s + 7]);
        const bf16x8 pf = __builtin_bit_cast(bf16x8, pw);
        __builtin_amdgcn_sched_barrier(0);
        __builtin_amdgcn_s_setprio(1);
#pragma unroll
        for (int db = 0; db < NDB; ++db) {
            const s16x4 lo = vlo[k & 1][db], hi = vhi[k & 1][db];
            const bf16x8 vf = (bf16x8){lo[0], lo[1], lo[2], lo[3], hi[0], hi[1], hi[2], hi[3]};
            O[db] = MFMA32(vf, pf, O[db]);
        }
        __builtin_amdgcn_s_setprio(0);
    }
#undef SPV_LOADV
}

constexpr float ALIBI_SKIP_BITS = 64.0f;
DI void diff_attn_phase(LAS unsigned char* lds, const bf16_t* qkv, bf16_t* mix, const float* lamp, const float* subg, const float* qg, const float* kg, float lam_init, unsigned* queue) {
    int tid = threadIdx.x; asm volatile("" : "+v"(tid));
    const int lane = tid & 63, wave = __builtin_amdgcn_readfirstlane(tid >> 6), r = lane & 31, hh = lane >> 5, i16 = lane & 15, blk = (lane >> 4) & 1;
    const int mp = wave & 1, rg = wave >> 1;
    float lam, B2;
    { const float s1 = wave_sum(lamp[lane] * lamp[64 + lane]), s2 = wave_sum(lamp[128 + lane] * lamp[192 + lane]); lam = expf(s1) - expf(s2) + lam_init;
      float gq = fabsf(qg[lane]), gk = fabsf(kg[lane]);
#pragma unroll
      for (int o = 1; o < 64; o <<= 1) { gq = fmaxf(gq, __shfl_xor(gq, o)); gk = fmaxf(gk, __shfl_xor(gk, o)); }
      B2 = 8.0f * LOG2E * gq * gk * 1.01f + 0.5f; }
    const bool fixed_ref = B2 < 40.0f;
    constexpr int KP = 272, VP = 320, KB = 64 * KP, VB = 64 * VP, BUF = KB + VB;
    LAS unsigned* qword = (LAS unsigned*)(lds + 2 * BUF);
    for (;;) {
        if (tid == 0) *qword = __hip_atomic_fetch_add(queue, 1u, __ATOMIC_RELAXED, __HIP_MEMORY_SCOPE_AGENT);
        __syncthreads();
        const int item = (int)*qword;
        if (item >= 1024) break;
        const int qb = 31 - (item >> 5), bh = item & 31, b = bh >> 2, h = bh & 3;
        const float slope2 = exp2f(-2.0f * (float)(h + 1)) * LOG2E;
        const size_t rowbase = (size_t)b * SEQ;
        {
            const int q0 = qb * 128, tq0 = q0 + 32 * rg, t = tq0 + r;
            bf16x8 qf[4];
            { const bf16_t* qp = qkv + (rowbase + t) * AB_IN + h * 128 + mp * 64 + hh * 8;
#pragma unroll
              for (int st = 0; st < 4; ++st) qf[st] = *(const bf16x8*)(qp + st * 16); }
            const int NT = (q0 + 128) / 64;
            const int wk = (int)fminf((2.0f * B2 + ALIBI_SKIP_BITS) / slope2 + 1.0f, 1.0e6f);
            const int tt0 = (q0 - wk) > 0 ? (q0 - wk) / 64 : 0;
            const bf16_t* gk_ = qkv + rowbase * AB_IN + 512 + h * 128;
            const bf16_t* gv_ = qkv + rowbase * AB_IN + 1024 + h * 128;
            u32x4 kreg[2], vreg[2];
#define DA_LOAD(tt) do { _Pragma("unroll") for (int i = 0; i < 2; ++i) { const int c = tid + 512 * i, row = c >> 4, cc = c & 15; \
                kreg[i] = *(const u32x4*)(gk_ + (size_t)((tt) * 64 + row) * AB_IN + cc * 8); vreg[i] = *(const u32x4*)(gv_ + (size_t)((tt) * 64 + row) * AB_IN + cc * 8); } } while (0)
#define DA_STORE(buf) do { _Pragma("unroll") for (int i = 0; i < 2; ++i) { const int c = tid + 512 * i, row = c >> 4, cc = c & 15; \
                *(LAS u32x4*)(lds + (buf) * BUF + row * KP + cc * 16) = kreg[i]; *(LAS u32x4*)(lds + (buf) * BUF + KB + row * VP + cc * 16) = vreg[i]; } } while (0)
            float m = -B2, l = 0.f; f32x16 O[4];
#pragma unroll
            for (int db = 0; db < 4; ++db) O[db] = (f32x16){};
            DA_LOAD(tt0); DA_STORE(tt0 & 1); __syncthreads();
            asm volatile("" : "+v"(qf[0]), "+v"(qf[1]), "+v"(qf[2]), "+v"(qf[3]));
            for (int tt = tt0; tt < NT; ++tt) {
                const int buf = tt & 1, kv0 = tt * 64;
                if (tt + 1 < NT) DA_LOAD(tt + 1);
                if (kv0 <= tq0 + 31) {
                    LAS const char* kb = (LAS const char*)lds + buf * BUF + r * KP + hh * 16 + mp * 128;
                    LAS const char* vb = (LAS const char*)lds + buf * BUF + KB + (4 * hh + (i16 >> 2)) * VP + 32 * blk + 8 * (i16 & 3);
                    const int dt0 = t - kv0;
                    f32x16 S[2];
                    qk_multi<0, 2, 2, KP>(S, kb, qf, slope2, dt0, hh, m);
                    if (kv0 + 63 > tq0) { mask_chunk<(1 << 30)>(S[0], dt0, hh, -(1 << 30)); mask_chunk<(1 << 30)>(S[1], dt0 - 32, hh, -(1 << 30)); }
                    if (fixed_ref) softmax_pv<2, 4, VP, true>(S, m, l, O, vb); else softmax_pv<2, 4, VP, false>(S, m, l, O, vb);
                }
                if (tt + 1 < NT) DA_STORE(buf ^ 1);
                __syncthreads();
            }
#undef DA_LOAD
#undef DA_STORE
            const float lt = xhalf_sum(l);
            const float inv = (mp ? lam : 1.0f) / lt;
            LAS float* X = (LAS float*)lds + rg * 4096;
            if (mp) {
#pragma unroll
                for (int db = 0; db < 4; ++db)
#pragma unroll
                    for (int i = 0; i < 16; ++i) X[(db * 16 + i) * 64 + lane] = O[db][i] * inv;
            }
            __syncthreads();
            if (!mp) {
                float ss = 0.f;
#pragma unroll
                for (int db = 0; db < 4; ++db)
#pragma unroll
                    for (int i = 0; i < 16; ++i) { const float a = O[db][i] * inv - X[(db * 16 + i) * 64 + lane]; O[db][i] = a; ss += a * a; }
                ss = xhalf_sum(ss);
                const float rn = rsqrtf(ss * (1.0f / 128.0f) + EPS) * (1.0f - lam_init);
                bf16_t* op = mix + (rowbase + t) * DM + h * 128 + 4 * hh;
#pragma unroll
                for (int db = 0; db < 4; ++db)
#pragma unroll
                    for (int g4 = 0; g4 < 4; ++g4) {
                        const int d0 = 32 * db + 8 * g4;
                        const f32x4 sg = *(const f32x4*)(subg + d0 + 4 * hh);
                        u32x2 w; w.x = cvtpk(O[db][4 * g4] * rn * sg[0], O[db][4 * g4 + 1] * rn * sg[1]); w.y = cvtpk(O[db][4 * g4 + 2] * rn * sg[2], O[db][4 * g4 + 3] * rn * sg[3]);
                        *(u32x2*)(op + d0) = w;
                    }
            }
            __syncthreads();
        }
    }
}
template <int W> DI void pool_item(const bf16_t* up, bf16_t* op, int tpos0) {
    u32x4 v[W + 7];
#pragma unroll
    for (int j = 0; j < W + 7; ++j) { v[j] = (u32x4){0u, 0u, 0u, 0u}; if (tpos0 + j - (W - 1) >= 0) v[j] = *(const u32x4*)(up + (ptrdiff_t)(j - (W - 1)) * AB_IN); }
    float sum[8];
#pragma unroll
    for (int c = 0; c < 8; ++c) sum[c] = 0.f;
#define PL_ACC(SGN, X) do { sum[0] += SGN bf_lo((X).x); sum[1] += SGN bf_hi((X).x); sum[2] += SGN bf_lo((X).y); sum[3] += SGN bf_hi((X).y); \
                            sum[4] += SGN bf_lo((X).z); sum[5] += SGN bf_hi((X).z); sum[6] += SGN bf_lo((X).w); sum[7] += SGN bf_hi((X).w); } while (0)
#pragma unroll
    for (int j = 0; j < W - 1; ++j) PL_ACC(+, v[j]);
#pragma unroll
    for (int r = 0; r < 8; ++r) {
        const u32x4 own = v[W - 1 + r];
        PL_ACC(+, own);
        const int cnt = (tpos0 + r + 1 < W) ? tpos0 + r + 1 : W;
        const float rn = 1.0f / (float)cnt;
        u32x4 o; o.x = cvtpk(sum[0] * rn - bf_lo(own.x), sum[1] * rn - bf_hi(own.x)); o.y = cvtpk(sum[2] * rn - bf_lo(own.y), sum[3] * rn - bf_hi(own.y));
        o.z = cvtpk(sum[4] * rn - bf_lo(own.z), sum[5] * rn - bf_hi(own.z)); o.w = cvtpk(sum[6] * rn - bf_lo(own.w), sum[7] * rn - bf_hi(own.w));
        *(u32x4*)(op + (size_t)r * DM) = o;
        PL_ACC(-, v[r]);
    }
#undef PL_ACC
}
DI void pool_phase(const bf16_t* qkv, bf16_t* mix, int G, int bid) {
    int tid = threadIdx.x; asm volatile("" : "+v"(tid));
    const int lane = tid & 63, wave = __builtin_amdgcn_readfirstlane(tid >> 6);
    for (int it = bid * 8 + wave; it < 4 * (MTOK / 32); it += G * 8) {
        const int g = it & 3, row0 = (it >> 2) * 32 + (lane >> 4) * 8, ch = g * 128 + (lane & 15) * 8;
        const bf16_t* up = qkv + (size_t)row0 * AB_IN + 1536 + ch; bf16_t* op = mix + (size_t)row0 * DM + 512 + ch;
        const int tpos0 = row0 & (SEQ - 1);
        if (g == 0) pool_item<2>(up, op, tpos0); else if (g == 1) pool_item<4>(up, op, tpos0); else if (g == 2) pool_item<8>(up, op, tpos0); else pool_item<16>(up, op, tpos0);
    }
}
DI void swa_phase(LAS unsigned char* lds, const bf16_t* qkv, bf16_t* mix, const float* sinks, const float* qg, const float* kg, int G, int bid) {
    int tid = threadIdx.x; asm volatile("" : "+v"(tid));
    const int lane = tid & 63, wave = __builtin_amdgcn_readfirstlane(tid >> 6), r = lane & 31, hh = lane >> 5, i16 = lane & 15, blk = (lane >> 4) & 1;
    constexpr int KP = 144, VP = 192, KB = 256 * KP;
    float B2;
    { float gq = fabsf(qg[lane]), gk = fabsf(kg[lane]);
#pragma unroll
      for (int o = 1; o < 64; o <<= 1) { gq = fmaxf(gq, __shfl_xor(gq, o)); gk = fmaxf(gk, __shfl_xor(gk, o)); }
      B2 = 8.0f * LOG2E * gq * gk * 1.01f + 0.5f; }
    for (int unit = bid; unit < 512; unit += G) {
        const int qb = unit & 31, kvh = (unit >> 5) & 1, b = unit >> 6;
        const int t0 = qb * 128; const size_t rowbase = (size_t)b * SEQ;
#pragma unroll
        for (int i = 0; i < 4; ++i) {
            const int c = tid + 512 * i, row = c >> 3, cc = c & 7, kvpos = t0 - 128 + row;
            u32x4 kx = (u32x4){0u, 0u, 0u, 0u}, vx = kx;
            if (kvpos >= 0) { const bf16_t* p = qkv + (rowbase + kvpos) * C_IN + 1024 + kvh * 64 + cc * 8; kx = *(const u32x4*)p; vx = *(const u32x4*)(p + 128); }
            *(LAS u32x4*)(lds + row * KP + cc * 16) = kx; *(LAS u32x4*)(lds + KB + row * VP + cc * 16) = vx;
        }
        __syncthreads();
        const int head = kvh * 8 + wave;
        const float slope2 = exp2f(-0.5f * (float)(head + 1)) * LOG2E, sink2 = sinks[head] * LOG2E;
        const bool fixed_ref = B2 < 40.0f && fabsf(sink2) < 40.0f;
        bf16x8 qf[4], qn[4];
        { const bf16_t* qp = qkv + (rowbase + t0 + r) * C_IN + head * 64 + hh * 8;
#pragma unroll
          for (int st = 0; st < 4; ++st) qf[st] = *(const bf16x8*)(qp + st * 16); }
#pragma unroll 1
        for (int j_ = 0; j_ < 4; ++j_) {
            int j = j_; asm volatile("" : "+s"(j));
            const int tq0 = t0 + 32 * j, t = tq0 + r;
            { const bf16_t* qp = qkv + (rowbase + (j < 3 ? t + 32 : t)) * C_IN + head * 64 + hh * 8;
#pragma unroll
              for (int st = 0; st < 4; ++st) qn[st] = *(const bf16x8*)(qp + st * 16); }
            asm volatile("" : "+v"(qf[0]), "+v"(qf[1]), "+v"(qf[2]), "+v"(qf[3]));
            float m = fixed_ref ? -B2 : sink2, l = hh == 0 ? (fixed_ref ? __builtin_amdgcn_exp2f(sink2 + B2) : 1.0f) : 0.0f; f32x16 O[2]; O[0] = (f32x16){}; O[1] = (f32x16){};
            {
                const int kvc0 = t0 - 128 + 32 * j;
                LAS const char* kb = (LAS const char*)lds + (32 * j + r) * KP + hh * 16;
                LAS const char* vb = (LAS const char*)lds + KB + (32 * j + 4 * hh + (i16 >> 2)) * VP + 32 * blk + 8 * (i16 & 3);
                int dt0 = t - kvc0; asm volatile("" : "+v"(dt0));
                f32x16 S[5];
                qk_multi<0, 3, 5, KP>(S, kb, qf, slope2, dt0, hh, m); qk_multi<3, 2, 5, KP>(S, kb, qf, slope2, dt0, hh, m);
                mask_chunk<128>(S[0], dt0, hh, -kvc0);
                mask_chunk<128>(S[4], dt0 - 128, hh, -kvc0 - 128);
                if (kvc0 < 0) {
#pragma unroll
                    for (int c = 1; c < 4; ++c) mask_chunk<128>(S[c], dt0 - 32 * c, hh, -kvc0 - 32 * c);
                }
                if (fixed_ref) softmax_pv<5, 2, VP, true>(S, m, l, O, vb); else softmax_pv<5, 2, VP, false>(S, m, l, O, vb);
            }
            const float inv = 1.0f / xhalf_sum(l);
            bf16_t* op = mix + (rowbase + t) * DM + head * 64 + 4 * hh;
#pragma unroll
            for (int db = 0; db < 2; ++db)
#pragma unroll
                for (int g4 = 0; g4 < 4; ++g4) {
                    u32x2 w; w.x = cvtpk(O[db][4 * g4] * inv, O[db][4 * g4 + 1] * inv); w.y = cvtpk(O[db][4 * g4 + 2] * inv, O[db][4 * g4 + 3] * inv);
                    *(u32x2*)(op + 32 * db + 8 * g4) = w;
                }
#pragma unroll
            for (int st = 0; st < 4; ++st) qf[st] = qn[st];
        }
        __syncthreads();
    }
}
DI void fixup_phase(const float* hb, const float* cw, const float* cb, bf16_t* act, int G, int bid) {
    int tid = threadIdx.x; asm volatile("" : "+v"(tid));
    const int nth = G * 512;
    for (int idx = bid * 512 + tid; idx < 512 * (DFF / 4); idx += nth) {
        const int f4 = idx % (DFF / 4), seg = idx / (DFF / 4), ff = 4 * f4;
        if ((seg & 63) == 0) continue;
        const float* a0 = hb + (size_t)(seg * 4) * NUP + ff;
        const float* a1 = a0 + NUP;
        const float* p2 = hb + (size_t)((seg - 1) * 4 + 2) * NUP + ff;
        const float* p3 = p2 + NUP;
        const f32x4 g0 = *(const f32x4*)a0, g1 = *(const f32x4*)a1, gp2 = *(const f32x4*)p2, gp3 = *(const f32x4*)p3;
        const f32x4 u0 = *(const f32x4*)(a0 + DFF), u1 = *(const f32x4*)(a1 + DFF), up2 = *(const f32x4*)(p2 + DFF), up3 = *(const f32x4*)(p3 + DFF);
        const f32x4 wg0 = *(const f32x4*)(cw + ff), wg1 = *(const f32x4*)(cw + NUP + ff), wg2 = *(const f32x4*)(cw + 2 * NUP + ff), bg = *(const f32x4*)(cb + ff);
        const f32x4 wu0 = *(const f32x4*)(cw + DFF + ff), wu1 = *(const f32x4*)(cw + NUP + DFF + ff), wu2 = *(const f32x4*)(cw + 2 * NUP + DFF + ff), bu = *(const f32x4*)(cb + DFF + ff);
        const f32x4 gate0 = bg + wg0 * gp2 + wg1 * gp3 + wg2 * g0, upv0 = bu + wu0 * up2 + wu1 * up3 + wu2 * u0;
        const f32x4 gate1 = bg + wg0 * gp3 + wg1 * g0 + wg2 * g1, upv1 = bu + wu0 * up3 + wu1 * u0 + wu2 * u1;
        float a[4], b[4];
#pragma unroll
        for (int i = 0; i < 4; ++i) {
            a[i] = gate0[i] * __builtin_amdgcn_rcpf(1.0f + __builtin_amdgcn_exp2f(-gate0[i] * LOG2E)) * upv0[i];
            b[i] = gate1[i] * __builtin_amdgcn_rcpf(1.0f + __builtin_amdgcn_exp2f(-gate1[i] * LOG2E)) * upv1[i];
        }
        u32x2 w0, w1; w0.x = cvtpk(a[0], a[1]); w0.y = cvtpk(a[2], a[3]); w1.x = cvtpk(b[0], b[1]); w1.y = cvtpk(b[2], b[3]);
        bf16_t* op = act + (size_t)(seg * 64) * DFF + ff;
        *(u32x2*)op = w0; *(u32x2*)(op + DFF) = w1;
    }
}

DI void transpose_item64(const float* W, int ldw, const float* gain, bf16_t* WT, int ldk, int k0, int n0, int wtA, int wtB, LAS float* scr, int lane) {
    const int c4 = (lane & 15) * 4, rl = lane >> 4;
    f32x4 v[16];
#pragma unroll
    for (int i = 0; i < 16; ++i) v[i] = *(const f32x4*)(W + (size_t)(k0 + 4 * i + rl) * ldw + n0 + c4);
    if (gain) {
#pragma unroll
        for (int i = 0; i < 16; ++i) v[i] = v[i] * gain[k0 + 4 * i + rl];
    }
#pragma unroll
    for (int i = 0; i < 16; ++i) *(LAS f32x4*)(scr + (4 * i + rl) * 68 + c4) = v[i];
    asm volatile("s_waitcnt lgkmcnt(0)" ::: "memory");
    bf16_t* dst = WT + (size_t)((lane < 32 ? wtA : wtB - 32) + lane) * ldk + k0;
#pragma unroll
    for (int c = 0; c < 8; ++c) { const LAS float* sp = scr + (8 * c) * 68 + lane;
        u32x4 o; o.x = cvtpk(sp[0 * 68], sp[1 * 68]); o.y = cvtpk(sp[2 * 68], sp[3 * 68]); o.z = cvtpk(sp[4 * 68], sp[5 * 68]); o.w = cvtpk(sp[6 * 68], sp[7 * 68]);
        *(u32x4*)(dst + 8 * c) = o; }
    asm volatile("s_waitcnt lgkmcnt(0)" ::: "memory");
}
DI void pairmap(int kind, int p, int& n0, int& wtA, int& wtB) {
    if (kind == 1) { const int pn = p >> 2, wc = p & 3; n0 = 256 * pn + 64 * wc; wtA = 32 * (8 * pn + wc); wtB = wtA + 128; }
    else if (kind == 2) { const int pn = p >> 2, bj = (p >> 1) & 1, w2 = p & 1; n0 = bj * DFF + 128 * pn + 64 * w2; wtA = 32 * (8 * pn + 4 * bj + 2 * w2); wtB = wtA + 32; }
    else { n0 = 64 * p; wtA = 64 * p; wtB = wtA + 32; }
}
#define XB_TMO      128
#define XB_XCNT(j)  (256  + 64 * (j))
#define XB_XSUB(j)  (1280 + 64 * (j))
#define XB_XGEN(j)  (2304 + 64 * (j))
#define XB_TOP      3328
#define XB_TOPGEN   3392
#define XCD_BAR_WORDS 3456
#define XB_SPIN_CAP (1u << 18)
DI unsigned xb_ld(unsigned* p)              { return __hip_atomic_load(p, __ATOMIC_RELAXED, __HIP_MEMORY_SCOPE_AGENT); }
DI unsigned xb_add(unsigned* p, unsigned v) { return __hip_atomic_fetch_add(p, v, __ATOMIC_RELAXED, __HIP_MEMORY_SCOPE_AGENT); }
DI unsigned xb_xcc_id() { return (unsigned)__builtin_amdgcn_s_getreg((3 << 11) | 20) & 0xFu; }
#define XB_SPIN(cond, bar) do { unsigned _sp = 0; while (cond) { __builtin_amdgcn_s_sleep(1); \
    if ((++_sp & 255u) == 0u) { if (xb_ld(&(bar)[XB_TMO])) break; if (_sp > XB_SPIN_CAP) { atomicAdd(&(bar)[XB_TMO], 1u); break; } } } } while (0)
struct XcdBarrier { unsigned* bar; unsigned x; volatile LAS unsigned* st; };
DI XcdBarrier xcd_barrier_post(unsigned* bar, volatile LAS unsigned* st) {
    XcdBarrier b; b.bar = bar; b.x = xb_xcc_id(); b.st = st;
    if (threadIdx.x == 0) (void)xb_add(&bar[XB_XCNT(b.x)], 1u);
    return b;
}
DI void xcd_barrier_complete(unsigned* bar, unsigned x, unsigned& nloc, unsigned& nx) {
    const unsigned G = gridDim.x * gridDim.y * gridDim.z;
    unsigned sum, cnt, mine, sp = 0u;
    for (;;) {
        sum = 0u; cnt = 0u; mine = 0u;
#pragma unroll
        for (unsigned j = 0; j < 16; ++j) { const unsigned c = xb_ld(&bar[XB_XCNT(j)]); sum += c; cnt += (c > 0u) ? 1u : 0u; mine = (j == x) ? c : mine; }
        if (sum == G) break;
        __builtin_amdgcn_s_sleep(1);
        if ((++sp & 255u) == 0u) { if (xb_ld(&bar[XB_TMO])) break; if (sp > XB_SPIN_CAP) { atomicAdd(&bar[XB_TMO], 1u); break; } }
    }
    nloc = mine > 0u ? mine : 1u; nx = cnt > 0u ? cnt : 1u;
}
DI void xcd_barrier(const XcdBarrier& b) {
    asm volatile("s_waitcnt vmcnt(0)" ::: "memory");
    __syncthreads();
    if (threadIdx.x == 0) {
        unsigned* bar = b.bar;
        __builtin_amdgcn_s_waitcnt(0);
        unsigned nloc = b.st[0], nx = b.st[1];
        if (nloc == 0u) { xcd_barrier_complete(bar, b.x, nloc, nx); b.st[0] = nloc; b.st[1] = nx; }
        const unsigned old = xb_add(&bar[XB_XSUB(b.x)], 1u);
        const unsigned gen = old / nloc;
        if (old + 1u == (gen + 1u) * nloc) {
            __builtin_amdgcn_fence(__ATOMIC_RELEASE, "agent");
            asm volatile("s_waitcnt vmcnt(0)" ::: "memory");
            const unsigned og = xb_add(&bar[XB_TOP], 1u);
            const unsigned tg = og / nx;
            if (og + 1u == (tg + 1u) * nx) xb_add(&bar[XB_TOPGEN], 1u);
            else XB_SPIN(xb_ld(&bar[XB_TOPGEN]) == tg, bar);
            __builtin_amdgcn_fence(__ATOMIC_ACQUIRE, "agent");
            xb_add(&bar[XB_XGEN(b.x)], 1u);
            asm volatile("s_waitcnt vmcnt(0)" ::: "memory");
        } else {
            XB_SPIN(xb_ld(&bar[XB_XGEN(b.x)]) == gen, bar);
            __builtin_amdgcn_fence(__ATOMIC_ACQUIRE, "agent");
            asm volatile("s_waitcnt vmcnt(0)" ::: "memory");
        }
    }
    __syncthreads();
}
struct Args {
    const float* in[21]; float* out; unsigned char* ws; int ph_lo, ph_hi;
};
constexpr int NPHASE = 1 + 6 * DEPTH;
constexpr int LDS_BYTES = 147456;

DI void prologue(const Args& A, LAS unsigned char* lds, int G, int bid) {
    const int tid = threadIdx.x, lane = tid & 63, wave = tid >> 6;
    unsigned char* ws = A.ws;
    LAS float* scr = (LAS float*)(lds + wave * 17408);
    const int gw = bid * 8 + wave, NGW = G * 8;
    constexpr int I_ABIN = 16 * 32, I_ABOUT = 8 * 16, I_CIN = 16 * 20, I_COUT = 16 * 16, I_UP = 16 * 88, I_DOWN = 44 * 16;
    constexpr int NITEMS = 2 * I_ABIN + 2 * I_ABOUT + 2 * I_CIN + 2 * I_COUT + 4 * I_UP + 4 * I_DOWN;
    for (int it = gw; it < NITEMS; it += NGW) {
        int rI = it, n0, wtA, wtB;
        if (rI < 2 * I_ABIN) { const int e = rI / I_ABIN, q = rI % I_ABIN, kb = q / 32; pairmap(1, q % 32, n0, wtA, wtB);
            transpose_item64(A.in[2] + (size_t)e * DM * AB_IN, AB_IN, A.in[1] + e * DM, (bf16_t*)(ws + WS_W_ABIN) + (size_t)e * AB_IN * DM, DM, kb * 64, n0, wtA, wtB, scr, lane); continue; }
        rI -= 2 * I_ABIN;
        if (rI < 2 * I_ABOUT) { const int e = rI / I_ABOUT, q = rI % I_ABOUT, kb = q / 16; pairmap(0, q % 16, n0, wtA, wtB);
            transpose_item64(A.in[9] + (size_t)e * DM * DM, DM, nullptr, (bf16_t*)(ws + WS_W_ABOUT) + (size_t)e * DM * DM, DM, kb * 64, n0, wtA, wtB, scr, lane); continue; }
        rI -= 2 * I_ABOUT;
        if (rI < 2 * I_CIN) { const int e = rI / I_CIN, q = rI % I_CIN, kb = q / 20; pairmap(1, q % 20, n0, wtA, wtB);
            transpose_item64(A.in[11] + (size_t)e * DM * C_IN, C_IN, A.in[10] + e * DM, (bf16_t*)(ws + WS_W_CIN) + (size_t)e * C_IN * DM, DM, kb * 64, n0, wtA, wtB, scr, lane); continue; }
        rI -= 2 * I_CIN;
        if (rI < 2 * I_COUT) { const int e = rI / I_COUT, q = rI % I_COUT, kb = q / 16; pairmap(0, q % 16, n0, wtA, wtB);
            transpose_item64(A.in[15] + (size_t)e * DM * DM, DM, nullptr, (bf16_t*)(ws + WS_W_COUT) + (size_t)e * DM * DM, DM, kb * 64, n0, wtA, wtB, scr, lane); continue; }
        rI -= 2 * I_COUT;
        if (rI < 4 * I_UP) { const int e = rI / I_UP, q = rI % I_UP, kb = q / 88; pairmap(2, q % 88, n0, wtA, wtB);
            transpose_item64(A.in[17] + (size_t)e * DM * NUP, NUP, A.in[16] + e * DM, (bf16_t*)(ws + WS_W_UP) + (size_t)e * NUP * DM, DM, kb * 64, n0, wtA, wtB, scr, lane); continue; }
        rI -= 4 * I_UP;
        { const int e = rI / I_DOWN, q = rI % I_DOWN, kb = q / 16; pairmap(0, q % 16, n0, wtA, wtB);
            transpose_item64(A.in[20] + (size_t)e * DFF * DM, DM, nullptr, (bf16_t*)(ws + WS_W_DOWN) + (size_t)e * DM * DFF, DFF, kb * 64, n0, wtA, wtB, scr, lane); }
    }
    const int nth = G * 512;
    for (int it = gw; it < 2 * 4 * 16 * 16; it += NGW) {
        const int n = (it & 15) * 64 + lane, c0 = ((it >> 4) & 15) * 8, g = (it >> 8) & 3, e = it >> 10;
        const float* wg = A.in[7] + ((size_t)(e * 4 + g) * 128 + c0) * 128;
        const float* sc = A.in[8] + e * 512 + 128 * g;
        const float* wo = A.in[9] + (size_t)e * DM * DM + (size_t)(512 + 128 * g) * DM + n;
        float acc[8];
#pragma unroll
        for (int j = 0; j < 8; ++j) acc[j] = 0.f;
        for (int d0 = 0; d0 < 128; d0 += 16) {
            float w[16];
#pragma unroll
            for (int dd = 0; dd < 16; ++dd) w[dd] = wo[(size_t)(d0 + dd) * DM];
#pragma unroll
            for (int dd = 0; dd < 16; ++dd) {
                const float ws_ = w[dd] * sc[d0 + dd];
#pragma unroll
                for (int j = 0; j < 8; ++j) acc[j] += wg[j * 128 + d0 + dd] * ws_;
            }
        }
        u32x4 o; o.x = cvtpk(acc[0], acc[1]); o.y = cvtpk(acc[2], acc[3]); o.z = cvtpk(acc[4], acc[5]); o.w = cvtpk(acc[6], acc[7]);
        *(u32x4*)((bf16_t*)(ws + WS_W_ABOUT) + (size_t)e * DM * DM + (size_t)n * DM + 512 + 128 * g + c0) = o;
    }
    float* rowss = (float*)(ws + WS_ROWSS);
    bf16_t* xb = (bf16_t*)(ws + WS_XB);
    for (int mrow = gw; mrow < MTOK; mrow += 2 * NGW) {
        const bool has2 = mrow + NGW < MTOK; const int mrow2 = has2 ? mrow + NGW : mrow;
        const f32x4* xr0 = (const f32x4*)(A.in[0] + (size_t)mrow * DM) + lane;
        const f32x4* xr1 = (const f32x4*)(A.in[0] + (size_t)mrow2 * DM) + lane;
        f32x4 v0[4], v1[4];
#pragma unroll
        for (int j = 0; j < 4; ++j) { v0[j] = xr0[64 * j]; v1[j] = xr1[64 * j]; }
        u32x2* o0 = (u32x2*)(xb + (size_t)mrow * DM) + lane; u32x2* o1 = (u32x2*)(xb + (size_t)mrow2 * DM) + lane;
        float s0 = 0.f, s1 = 0.f;
#pragma unroll
        for (int j = 0; j < 4; ++j) {
            s0 += (v0[j][0] * v0[j][0] + v0[j][1] * v0[j][1]) + (v0[j][2] * v0[j][2] + v0[j][3] * v0[j][3]);
            s1 += (v1[j][0] * v1[j][0] + v1[j][1] * v1[j][1]) + (v1[j][2] * v1[j][2] + v1[j][3] * v1[j][3]);
            u32x2 w; w.x = cvtpk(v0[j][0], v0[j][1]); w.y = cvtpk(v0[j][2], v0[j][3]); o0[64 * j] = w;
            w.x = cvtpk(v1[j][0], v1[j][1]); w.y = cvtpk(v1[j][2], v1[j][3]); if (has2) o1[64 * j] = w;
        }
        s0 = wave_sum(s0); s1 = wave_sum(s1);
        if (lane < 16) { rowss[(size_t)mrow * 16 + lane] = lane == 0 ? s0 : 0.f; if (has2) rowss[(size_t)mrow2 * 16 + lane] = lane == 0 ? s1 : 0.f; }
    }
}

__global__ void __launch_bounds__(512) fwd_megakernel(Args A) {
    extern __shared__ __attribute__((aligned(16))) unsigned char lds_raw[];
    LAS unsigned char* lds = (LAS unsigned char*)lds_raw;
    cg::grid_group grid = cg::this_grid();
    const int G = gridDim.x, bid = blockIdx.x;
    unsigned char* ws = A.ws;
    float* rowss = (float*)(ws + WS_ROWSS);
    bf16_t* xb = (bf16_t*)(ws + WS_XB);
    bf16_t* qkv = (bf16_t*)(ws + WS_QKV);
    bf16_t* mix = (bf16_t*)(ws + WS_MIX);
    bf16_t* act = (bf16_t*)(ws + WS_ACT);
    float* hb = (float*)(ws + WS_HB);
    const int lo = A.ph_lo, hi = A.ph_hi;
#define IN(k) (lo <= (k) && (k) < hi)
    volatile LAS unsigned* bst = (volatile LAS unsigned*)(lds + LDS_BYTES - 64);
    if (threadIdx.x < 2) bst[threadIdx.x] = 0u;
    __syncthreads();
    const XcdBarrier xbar = xcd_barrier_post((unsigned*)(ws + WS_CTL) + 1024, bst);
    if (A.ph_hi < 0) grid.sync();
#define SEAM(k) do { if (IN(k) && IN((k) + 1)) xcd_barrier(xbar); } while (0)
    if (IN(0)) { prologue(A, lds, G, bid); __syncthreads(); }
    SEAM(0);
    for (int layer_ = 0; layer_ < DEPTH; ++layer_) {
        int layer = layer_; asm volatile("" : "+s"(layer));
        const int pb = 1 + 6 * layer, e = layer >> 1;
        const bool even = (layer & 1) == 0;
        if (IN(pb)) {
            pg8::StaticOrder S;
            if (even) {
                pg8::Gemm g{xb, (const bf16_t*)(ws + WS_W_ABIN) + (size_t)e * AB_IN * DM, MTOK, AB_IN, DM}; S.init(MTOK, AB_IN, G, bid);
                EpiQKV E{rowss + (size_t)(2 * layer) * MTOK * 16, A.in[3] + e * 64, A.in[4] + e * 64, qkv, AB_IN, 8, 16, (LAS float*)(lds + RTAB_OFF)};
                pg8::gemm_phase<EpiQKV>(lds, g, S, E);
            } else {
                pg8::Gemm g{xb, (const bf16_t*)(ws + WS_W_CIN) + (size_t)e * C_IN * DM, MTOK, C_IN, DM}; S.init(MTOK, C_IN, G, bid);
                EpiQKV E{rowss + (size_t)(2 * layer) * MTOK * 16, A.in[12] + e * 64, A.in[13] + e * 64, qkv, C_IN, 16, 18, (LAS float*)(lds + RTAB_OFF)};
                pg8::gemm_phase<EpiQKV>(lds, g, S, E);
            }
        }
        SEAM(pb);
        if (IN(pb + 1)) {
            if (even) {
                pool_phase(qkv, mix, G, bid);
                diff_attn_phase(lds, qkv, mix, A.in[5] + e * 256, A.in[6] + e * 128, A.in[3] + e * 64, A.in[4] + e * 64, 0.8f - 0.6f * expf(-0.3f * (float)layer), (unsigned*)(ws + WS_CTL) + 64 + 64 * e);
            } else {
                swa_phase(lds, qkv, mix, A.in[14] + e * 16, A.in[12] + e * 64, A.in[13] + e * 64, G, bid);
            }
        }
        SEAM(pb + 1);
        if (IN(pb + 2)) {
            pg8::StaticOrder S; S.init(MTOK, DM, G, bid);
            pg8::Gemm g{mix, (const bf16_t*)(ws + (even ? WS_W_ABOUT : WS_W_COUT)) + (size_t)e * DM * DM, MTOK, DM, DM};
            EpiRes E{layer == 0 ? A.in[0] : nullptr, xb, nullptr, rowss + (size_t)(2 * layer + 1) * MTOK * 16};
            pg8::gemm_phase<EpiRes>(lds, g, S, E);
        }
        SEAM(pb + 2);
        if (IN(pb + 3)) {
            pg8::StaticOrder S; S.init(MTOK, NUP, G, bid);
            pg8::Gemm g{xb, (const bf16_t*)(ws + WS_W_UP) + (size_t)layer * NUP * DM, MTOK, NUP, DM};
            EpiUp E{rowss + (size_t)(2 * layer + 1) * MTOK * 16, A.in[18] + (size_t)layer * 3 * NUP, A.in[19] + (size_t)layer * NUP, act, hb, (LAS float*)(lds + RTAB_OFF)};
            pg8::gemm_phase<EpiUp>(lds, g, S, E);
        }
        SEAM(pb + 3);
        if (IN(pb + 4)) fixup_phase(hb, A.in[18] + (size_t)layer * 3 * NUP, A.in[19] + (size_t)layer * NUP, act, G, bid);
        SEAM(pb + 4);
        if (IN(pb + 5)) {
            pg8::StaticOrder S; S.init(MTOK, DM, G, bid);
            pg8::Gemm g{act, (const bf16_t*)(ws + WS_W_DOWN) + (size_t)layer * DM * DFF, MTOK, DM, DFF};
            const bool lastl = layer == DEPTH - 1;
            EpiRes E{nullptr, xb, lastl ? A.out : nullptr, lastl ? nullptr : rowss + (size_t)(2 * layer + 2) * MTOK * 16};
            pg8::gemm_phase<EpiRes>(lds, g, S, E);
        }
        SEAM(pb + 5);
    }
#undef IN
#undef SEAM
}

extern "C" void kernel_launch(void* const* d_in, const int* in_sizes, int n_in, void* d_out, int out_size, void* d_ws, size_t ws_size, hipStream_t stream) {
    static int grid = 0;
    if (grid == 0) {
        if (n_in != 21 || out_size != MTOK * DM || ws_size < WS_END) { fprintf(stderr, "kernel_launch: unexpected shapes (n_in %d out %d ws %zu)\n", n_in, out_size, ws_size); grid = -1; return; }
        int dev = 0, cus = 0, per_cu = 0;
        hipGetDevice(&dev);
        hipDeviceGetAttribute(&cus, hipDeviceAttributeMultiprocessorCount, dev);
        hipFuncSetAttribute((const void*)fwd_megakernel, hipFuncAttributeMaxDynamicSharedMemorySize, LDS_BYTES);
        hipOccupancyMaxActiveBlocksPerMultiprocessor(&per_cu, (const void*)fwd_megakernel, 512, LDS_BYTES);
        if (per_cu < 1) per_cu = 1;
        grid = cus * per_cu;
        (void)hipGetLastError();
    }
    if (grid < 0) return;
    (void)hipMemsetAsync((char*)d_ws + WS_CTL, 0, 32768, stream);
    Args a{};
    for (int i = 0; i < 21; ++i) a.in[i] = (const float*)d_in[i];
    a.out = (float*)d_out; a.ws = (unsigned char*)d_ws; a.ph_lo = 0; a.ph_hi = NPHASE;
    void* args[] = {&a};
    hipError_t e = hipLaunchCooperativeKernel((const void*)fwd_megakernel, dim3(grid), dim3(512), args, LDS_BYTES, stream);
    if (e != hipSuccess) fprintf(stderr, "cooperative launch failed: %s (grid %d)\n", hipGetErrorString(e), grid);
}
```

```cpp
#include <hip/hip_runtime.h>
#include <hip/hip_cooperative_groups.h>
#include <cstdio>
#include <cstdint>
namespace cg = cooperative_groups;

#define LAS __attribute__((address_space(3)))
#define DI __device__ __forceinline__
typedef unsigned short bf16_t;
typedef short bf16x8 __attribute__((ext_vector_type(8)));
typedef short s16x4 __attribute__((ext_vector_type(4)));
typedef float f32x4 __attribute__((ext_vector_type(4)));
typedef float f32x2 __attribute__((ext_vector_type(2)));
typedef float f32x16 __attribute__((ext_vector_type(16)));
typedef unsigned u32x4 __attribute__((ext_vector_type(4)));
typedef unsigned u32x2 __attribute__((ext_vector_type(2)));
typedef __bf16 bf16x2_t __attribute__((ext_vector_type(2)));

constexpr int DM = 1024, BATCH = 8, SEQ = 4096, MTOK = BATCH * SEQ, DEPTH = 4;
constexpr int AB_IN = 2048, C_IN = 1280, DFF = 2816, NUP = 5632;
constexpr float EPS = 1e-6f;
constexpr float LOG2E = 1.4426950408889634f;
constexpr float QSCALE = 0.125f * LOG2E;

constexpr size_t MiB = 1u << 20;
constexpr size_t WS_W_ABIN = 0, WS_W_ABOUT = 8 * MiB, WS_W_CIN = 12 * MiB, WS_W_COUT = 17 * MiB, WS_W_UP = 21 * MiB, WS_W_DOWN = 65 * MiB;
constexpr size_t WS_ROWSS = 390 * MiB;
constexpr size_t WS_HB = 88 * MiB;
constexpr size_t WS_XB = 132 * MiB;
constexpr size_t WS_QKV = 196 * MiB;
constexpr size_t WS_MIX = 324 * MiB;
constexpr size_t WS_ACT = 196 * MiB;
constexpr size_t WS_CTL = 388 * MiB;
constexpr size_t WS_END = 406 * MiB;

DI unsigned cvtpk(float lo, float hi) { f32x2 v = {lo, hi}; bf16x2_t b = __builtin_convertvector(v, bf16x2_t); return __builtin_bit_cast(unsigned, b); }
DI float bf_lo(unsigned u) { return __uint_as_float(u << 16); }
DI float bf_hi(unsigned u) { return __uint_as_float(u & 0xffff0000u); }
DI float wave_sum(float v) {
#pragma unroll
    for (int o = 1; o < 64; o <<= 1) v += __shfl_xor(v, o);
    return v;
}
DI float xhalf_max(float v) { auto rr = __builtin_amdgcn_permlane32_swap(__float_as_uint(v), __float_as_uint(v), false, false); return fmaxf(__uint_as_float(rr[0]), __uint_as_float(rr[1])); }
DI float xhalf_sum(float v) { auto rr = __builtin_amdgcn_permlane32_swap(__float_as_uint(v), __float_as_uint(v), false, false); return __uint_as_float(rr[0]) + __uint_as_float(rr[1]); }

namespace pg8 {
constexpr int BM = 256, BK = 64, HALF = 128, HTB = HALF * BK * 2, STAGE_BYTES = 8 * HTB, NXCD = 8, WGM = 8;
__host__ __device__ __forceinline__ int lds_byte(int r, int c) { const int st = (r >> 4) * 2 + (c >> 5), rr = r & 15, cc = c & 31, ob = rr * 64 + cc * 2; return st * 1024 + (ob ^ (((ob >> 9) & 1) << 5)); }
__host__ __device__ __forceinline__ void stage_rc(int b, int& R, int& C) { const int st = b / 1024, sb = b % 1024, swz = sb ^ (((sb >> 9) & 1) << 5); R = (st >> 1) * 16 + swz / 64; C = (st & 1) * 32 + (swz % 64) / 2; }
__host__ __device__ __forceinline__ int perm32(int rho) { const int n = rho >> 4, i = rho & 15; return 8 * (i >> 2) + 4 * n + (i & 3); }
struct Unit { int pm, pn; };
struct Gemm { const bf16_t* A; const bf16_t* Bt; int M, N, K; };
struct StaticOrder {
    int nM, nN, nwg, G, c;
    __device__ void init(int M, int N, int G_, int c_) { nM = M / BM; nN = N / BM; nwg = nM * nN; G = G_; c = c_; }
    __device__ bool next(int i, Unit& u) const {
        const long L = (long)i * G + c; if (L >= nwg) return false;
        int wgid = (int)L; { const int q = nwg / NXCD, r = nwg % NXCD, xcd = wgid % NXCD, off = wgid / NXCD; wgid = (xcd < r ? xcd * (q + 1) : r * (q + 1) + (xcd - r) * q) + off; }
        const int nig = WGM * nN, gid = wgid / nig, fm = gid * WGM, gsz = (nM - fm) < WGM ? (nM - fm) : WGM;
        u.pm = fm + ((wgid % nig) % gsz); u.pn = (wgid % nig) / gsz; return true;
    }
};
template <class Epi>
__device__ __forceinline__ void gemm_phase(LAS unsigned char* lds, const Gemm g, const StaticOrder& S, const Epi& E) {
    int tid = threadIdx.x; asm volatile("" : "+v"(tid));
    const int wid = __builtin_amdgcn_readfirstlane(tid >> 6), lane = tid & 63, wr = wid >> 2, wc = wid & 3, fr = lane & 15, fq = lane >> 4;
    const int K = g.K, nt = K / BK;
    unsigned voffA[2], voffB[2];
#pragma unroll
    for (int i = 0; i < 2; ++i) { int R, C; stage_rc(tid * 16 + i * 8192, R, C); const int Rb = (R & ~31) + perm32(R & 31);
        voffA[i] = (unsigned)(R * K + C) * 2u; voffB[i] = (unsigned)(Rb * K + C) * 2u; }
    const size_t kstep = (size_t)(BK * 2);
    const size_t hstep = (size_t)HALF * K * 2;
    const size_t tstep = 2 * hstep;
    const unsigned ldsw = (unsigned)wid * 1024u;
    const int aoff = lds_byte(wr * 64 + fr, fq * 8), boff = lds_byte(wc * 32 + fr, fq * 8);
#define PG8_SA(b, h) (((b) * 2 + (h)) * HTB)
#define PG8_SB(b, h) ((4 + (b) * 2 + (h)) * HTB)
#define PG8_STAGE(bufoff, gbase, voff) do { _Pragma("unroll") for (int _i = 0; _i < 2; ++_i) \
        __builtin_amdgcn_global_load_lds((const unsigned*)((const char*)(gbase) + (voff)[_i]), (LAS unsigned*)(lds + (bufoff) + ldsw + _i * 8192), 16, 0, 0); } while (0)
#define PG8_LDA(dst, b, h) do { _Pragma("unroll") for (int m = 0; m < 4; ++m) _Pragma("unroll") for (int k = 0; k < 2; ++k) dst[m][k] = *(const LAS bf16x8*)(lds + PG8_SA(b, h) + aoff + m * 2048 + k * 1024); } while (0)
#define PG8_LDB(dst, b, h) do { _Pragma("unroll") for (int n = 0; n < 2; ++n) _Pragma("unroll") for (int k = 0; k < 2; ++k) dst[n][k] = *(const LAS bf16x8*)(lds + PG8_SB(b, h) + boff + n * 2048 + k * 1024); } while (0)
#define PG8_MMA(ai, bj, At, Bt) do { __builtin_amdgcn_s_setprio(1); _Pragma("unroll") for (int m = 0; m < 4; ++m) _Pragma("unroll") for (int n = 0; n < 2; ++n) _Pragma("unroll") for (int k = 0; k < 2; ++k) \
        acc[ai][bj][m][n] = __builtin_amdgcn_mfma_f32_16x16x32_bf16(Bt[n][k], At[m][k], acc[ai][bj][m][n], 0, 0, 0); __builtin_amdgcn_s_setprio(0); } while (0)
#define PG8_WAIT_V(n) asm volatile("s_waitcnt vmcnt(" #n ")" ::: "memory")
#define PG8_WAIT_L(n) asm volatile("s_waitcnt lgkmcnt(" #n ")" ::: "memory")
#define PG8_BAR __builtin_amdgcn_s_barrier()
#define PG8_SCHED __builtin_amdgcn_sched_barrier(0)
    Unit cur, nxt; int ui = 0;
    if (!S.next(0, cur)) return;
    f32x4 acc[2][2][4][2];
#pragma unroll
    for (int a = 0; a < 2; ++a)
#pragma unroll
        for (int b = 0; b < 2; ++b)
#pragma unroll
            for (int m = 0; m < 4; ++m)
#pragma unroll
                for (int n = 0; n < 2; ++n) acc[a][b][m][n] = (f32x4){0.f, 0.f, 0.f, 0.f};
    bf16x8 At[4][2], B0[2][2], B1[2][2];
    const char* cA = (const char*)g.A + (size_t)cur.pm * tstep; const char* cB = (const char*)g.Bt + (size_t)cur.pn * tstep;
    PG8_STAGE(PG8_SB(0, 0), cB, voffB); PG8_STAGE(PG8_SB(0, 1), cB + hstep, voffB); PG8_STAGE(PG8_SA(0, 0), cA, voffA); PG8_STAGE(PG8_SA(0, 1), cA + hstep, voffA);
    if (wr == 1) PG8_BAR;
    PG8_WAIT_V(2); PG8_BAR;
    PG8_STAGE(PG8_SB(1, 0), cB + kstep, voffB); PG8_STAGE(PG8_SA(1, 0), cA + kstep, voffA); PG8_STAGE(PG8_SB(1, 1), cB + hstep + kstep, voffB);
    PG8_WAIT_V(6); PG8_BAR;
    for (;;) {
        const bool has_next = S.next(ui + 1, nxt);
        const char* nA = has_next ? (const char*)g.A + (size_t)nxt.pm * tstep : cA; const char* nB = has_next ? (const char*)g.Bt + (size_t)nxt.pn * tstep : cB;
        for (int t = 0; t < nt; t += 2) {
            const bool last = (t == nt - 2);
            const char* a1 = cA + (size_t)(t + 1) * kstep;
            const char* a2 = last ? nA : cA + (size_t)(t + 2) * kstep; const char* b2 = last ? nB : cB + (size_t)(t + 2) * kstep;
            const char* a3 = a2 + kstep; const char* b3 = b2 + kstep;
            PG8_LDB(B0, 0, 0); PG8_LDB(B1, 0, 1); PG8_SCHED; PG8_LDA(At, 0, 0); PG8_STAGE(PG8_SA(1, 1), a1 + hstep, voffA);
            PG8_WAIT_V(8); PG8_WAIT_L(0); PG8_BAR; PG8_MMA(0, 0, At, B0); PG8_MMA(0, 1, At, B1); PG8_BAR; PG8_SCHED;
            PG8_LDA(At, 0, 1); PG8_STAGE(PG8_SB(0, 0), b2, voffB); PG8_STAGE(PG8_SB(0, 1), b2 + hstep, voffB); PG8_STAGE(PG8_SA(0, 0), a2, voffA);
            PG8_WAIT_V(8); PG8_WAIT_L(0); PG8_BAR; PG8_MMA(1, 0, At, B0); PG8_MMA(1, 1, At, B1); PG8_BAR; PG8_SCHED;
            PG8_LDB(B0, 1, 0); PG8_LDB(B1, 1, 1); PG8_SCHED; PG8_LDA(At, 1, 0); PG8_STAGE(PG8_SA(0, 1), a2 + hstep, voffA);
            PG8_WAIT_V(8); PG8_WAIT_L(0); PG8_BAR; PG8_MMA(0, 0, At, B0); PG8_MMA(0, 1, At, B1); PG8_BAR; PG8_SCHED;
            PG8_LDA(At, 1, 1); PG8_STAGE(PG8_SB(1, 0), b3, voffB); PG8_STAGE(PG8_SB(1, 1), b3 + hstep, voffB); PG8_STAGE(PG8_SA(1, 0), a3, voffA);
            PG8_WAIT_V(8); PG8_WAIT_L(0); PG8_BAR; PG8_MMA(1, 0, At, B0); PG8_MMA(1, 1, At, B1); PG8_BAR; PG8_SCHED;
        }
        if (wr == 0) PG8_BAR;
        E(acc, cur, wr, wc, fr, fq);
        if (!has_next) break;
#pragma unroll
        for (int a = 0; a < 2; ++a)
#pragma unroll
            for (int b = 0; b < 2; ++b)
#pragma unroll
                for (int m = 0; m < 4; ++m)
#pragma unroll
                    for (int n = 0; n < 2; ++n) acc[a][b][m][n] = (f32x4){0.f, 0.f, 0.f, 0.f};
        cur = nxt; cA = nA; cB = nB; ++ui;
        if (wr == 1) PG8_BAR;
    }
    PG8_WAIT_V(0);
    PG8_BAR;
#undef PG8_SA
#undef PG8_SB
#undef PG8_STAGE
#undef PG8_LDA
#undef PG8_LDB
#undef PG8_MMA
#undef PG8_WAIT_V
#undef PG8_WAIT_L
#undef PG8_BAR
#undef PG8_SCHED
}
}

constexpr int RTAB_OFF = 131072;
DI void rstd_table(const float* slots, LAS float* rtab, int pm, int wr, int wc, int fr, int fq, const float* cw = nullptr, const float* cb = nullptr, int pn = 0) {
    const int tid = (wr * 4 + wc) * 64 + fq * 16 + fr, rl = tid >> 1, hf = tid & 1;
    const f32x4* p = (const f32x4*)(slots + (size_t)(pm * 256 + rl) * 16 + hf * 8);
    const f32x4 a = p[0], b = p[1];
    if (cw) {
        float t[2];
#pragma unroll
        for (int k = 0; k < 2; ++k) { const int idx = tid + 512 * k, j = idx >> 8, x = idx & 255, col = (x >> 7) * DFF + 128 * pn + (x & 127); t[k] = (j < 3) ? cw[j * NUP + col] : cb[col]; }
        rtab[256 + tid] = t[0]; rtab[256 + 512 + tid] = t[1];
    }
    float ss = ((a[0] + a[1]) + (a[2] + a[3])) + ((b[0] + b[1]) + (b[2] + b[3]));
    ss += __shfl_xor(ss, 1);
    if (!hf) rtab[rl] = rsqrtf(ss * (1.0f / 1024.0f) + EPS);
    asm volatile("s_waitcnt lgkmcnt(0)" ::: "memory"); __builtin_amdgcn_s_barrier(); asm volatile("" ::: "memory");
}
struct EpiQKV {
    const float* rowss; const float* qg; const float* kg; bf16_t* out; int ld, nq, nqk; LAS float* rtab;
    DI void operator()(f32x4 (&acc)[2][2][4][2], const pg8::Unit& u, int wr, int wc, int fr, int fq) const {
        rstd_table(rowss, rtab, u.pm, wr, wc, fr, fq);
        const int grp = 4 * u.pn + wc;
        const int row0 = u.pm * 256 + wr * 64 + fr;
        const bool donorm = grp < nqk, isq = grp < nq;
        f32x4 g[2][2];
#pragma unroll
        for (int bj = 0; bj < 2; ++bj)
#pragma unroll
            for (int n = 0; n < 2; ++n) {
                f32x4 t = (f32x4){1.f, 1.f, 1.f, 1.f};
                if (donorm) { t = *(const f32x4*)((isq ? qg : kg) + 32 * bj + 8 * fq + 4 * n); if (isq) t = t * QSCALE; }
                g[bj][n] = t;
            }
#pragma unroll
        for (int ai = 0; ai < 2; ++ai)
#pragma unroll
            for (int m = 0; m < 4; ++m) {
                const int row = row0 + ai * 128 + m * 16;
                const float rstd = rtab[ai * 128 + wr * 64 + m * 16 + fr];
                f32x4 v[2][2]; float ss = 0.f;
#pragma unroll
                for (int bj = 0; bj < 2; ++bj)
#pragma unroll
                    for (int n = 0; n < 2; ++n) { v[bj][n] = acc[ai][bj][m][n] * rstd; const f32x4 x = v[bj][n]; ss += (x[0] * x[0] + x[1] * x[1]) + (x[2] * x[2] + x[3] * x[3]); }
                float rn = 1.f;
                if (donorm) { ss += __shfl_xor(ss, 16); ss += __shfl_xor(ss, 32); rn = rsqrtf(ss * (1.0f / 64.0f) + EPS); }
#pragma unroll
                for (int bj = 0; bj < 2; ++bj) {
                    const f32x4 o0 = v[bj][0] * rn * g[bj][0], o1 = v[bj][1] * rn * g[bj][1];
                    u32x4 w; w.x = cvtpk(o0[0], o0[1]); w.y = cvtpk(o0[2], o0[3]); w.z = cvtpk(o1[0], o1[1]); w.w = cvtpk(o1[2], o1[3]);
                    *(u32x4*)(out + (size_t)row * ld + 64 * grp + 32 * bj + 8 * fq) = w;
                }
            }
    }
};
struct EpiRes {
    const float* basef; bf16_t* xb; float* outf; float* rowss_out;
    DI void operator()(f32x4 (&acc)[2][2][4][2], const pg8::Unit& u, int wr, int wc, int fr, int fq) const {
        const int col0 = u.pn * 256 + wc * 32 + 8 * fq;
        const int row0 = u.pm * 256 + wr * 64 + fr;
        u32x4 bw[2][4][2];
        if (!basef) {
#pragma unroll
            for (int ai = 0; ai < 2; ++ai)
#pragma unroll
                for (int m = 0; m < 4; ++m)
#pragma unroll
                    for (int bj = 0; bj < 2; ++bj) bw[ai][m][bj] = *(const u32x4*)(xb + (size_t)(row0 + ai * 128 + m * 16) * DM + col0 + bj * 128);
            __builtin_amdgcn_sched_barrier(0);
        }
#pragma unroll
        for (int ai = 0; ai < 2; ++ai)
#pragma unroll
            for (int m = 0; m < 4; ++m) {
                const int row = row0 + ai * 128 + m * 16; float ss = 0.f;
#pragma unroll
                for (int bj = 0; bj < 2; ++bj) {
                    const size_t off = (size_t)row * DM + col0 + bj * 128;
                    f32x4 b0, b1;
                    if (basef) { b0 = *(const f32x4*)(basef + off); b1 = *(const f32x4*)(basef + off + 4); }
                    else { const u32x4 w = bw[ai][m][bj]; b0 = (f32x4){bf_lo(w.x), bf_hi(w.x), bf_lo(w.y), bf_hi(w.y)}; b1 = (f32x4){bf_lo(w.z), bf_hi(w.z), bf_lo(w.w), bf_hi(w.w)}; }
                    const f32x4 v0 = acc[ai][bj][m][0] + b0, v1 = acc[ai][bj][m][1] + b1;
                    if (outf) { *(f32x4*)(outf + off) = v0; *(f32x4*)(outf + off + 4) = v1; }
                    else { u32x4 w; w.x = cvtpk(v0[0], v0[1]); w.y = cvtpk(v0[2], v0[3]); w.z = cvtpk(v1[0], v1[1]); w.w = cvtpk(v1[2], v1[3]); *(u32x4*)(xb + off) = w; }
                    ss += (v0[0] * v0[0] + v0[1] * v0[1]) + (v0[2] * v0[2] + v0[3] * v0[3]) + (v1[0] * v1[0] + v1[1] * v1[1]) + (v1[2] * v1[2] + v1[3] * v1[3]);
                }
                if (rowss_out) { ss += __shfl_xor(ss, 16); ss += __shfl_xor(ss, 32); if (fq == 0) rowss_out[(size_t)row * 16 + u.pn * 4 + wc] = ss; }
            }
    }
};
template <int N> DI float shift_rows(float cur, float prev) {
    const int t = __builtin_amdgcn_mov_dpp(__float_as_int(prev), 0x120 + N, 0xf, 0xf, true);
    const int r = __builtin_amdgcn_update_dpp(t, __float_as_int(cur), 0x110 + N, 0xf, 0xf, false);
    return __int_as_float(r);
}
template <int N> DI float shift_rows0(float cur) {
    return __int_as_float(__builtin_amdgcn_update_dpp(0, __float_as_int(cur), 0x110 + N, 0xf, 0xf, true));
}
struct EpiUp {
    const float* rowss; const float* cw; const float* cb; bf16_t* act; float* hb; LAS float* rtab;
    DI void operator()(f32x4 (&acc)[2][2][4][2], const pg8::Unit& u, int wr, int wc, int fr, int fq) const {
        rstd_table(rowss, rtab, u.pm, wr, wc, fr, fq, cw, cb, u.pn);
        const int ff0 = 128 * u.pn + 32 * wc + 8 * fq;
        const int row0 = u.pm * 256 + wr * 64 + fr;
#pragma unroll
        for (int ai = 0; ai < 2; ++ai)
#pragma unroll
            for (int m = 0; m < 4; ++m) {
                const float rstd = rtab[ai * 128 + wr * 64 + m * 16 + fr];
#pragma unroll
                for (int bj = 0; bj < 2; ++bj)
#pragma unroll
                    for (int n = 0; n < 2; ++n) acc[ai][bj][m][n] = acc[ai][bj][m][n] * rstd;
            }
#pragma unroll
        for (int n = 0; n < 2; ++n) {
            const int colg = ff0 + 4 * n, colu = DFF + colg;
            const LAS float* ct = rtab + 256 + 32 * wc + 8 * fq + 4 * n;
            const f32x4 wg0 = *(const LAS f32x4*)(ct), wg1 = *(const LAS f32x4*)(ct + 256), wg2 = *(const LAS f32x4*)(ct + 512), bg = *(const LAS f32x4*)(ct + 768);
            const f32x4 wu0 = *(const LAS f32x4*)(ct + 128), wu1 = *(const LAS f32x4*)(ct + 384), wu2 = *(const LAS f32x4*)(ct + 640), bu = *(const LAS f32x4*)(ct + 896);
#pragma unroll
            for (int ai = 0; ai < 2; ++ai) {
                const int seg = u.pm * 4 + ai * 2 + wr;
#pragma unroll
                for (int m = 0; m < 4; ++m) {
                    const int row = row0 + ai * 128 + m * 16;
                    const f32x4 cg = acc[ai][0][m][n], cu = acc[ai][1][m][n];
                    f32x4 pg = (f32x4){0.f, 0.f, 0.f, 0.f}, pu = pg;
                    if (m > 0) { pg = acc[ai][0][m - 1][n]; pu = acc[ai][1][m - 1][n]; }
                    float a[4];
#pragma unroll
                    for (int i = 0; i < 4; ++i) {
                        float g1, g2, u1, u2;
                        if (m > 0) { g1 = shift_rows<1>(cg[i], pg[i]); g2 = shift_rows<2>(cg[i], pg[i]); u1 = shift_rows<1>(cu[i], pu[i]); u2 = shift_rows<2>(cu[i], pu[i]); }
                        else { g1 = shift_rows0<1>(cg[i]); g2 = shift_rows0<2>(cg[i]); u1 = shift_rows0<1>(cu[i]); u2 = shift_rows0<2>(cu[i]); }
                        const float gate = bg[i] + wg0[i] * g2 + wg1[i] * g1 + wg2[i] * cg[i];
                        const float upv = bu[i] + wu0[i] * u2 + wu1[i] * u1 + wu2[i] * cu[i];
                        a[i] = gate * __builtin_amdgcn_rcpf(1.0f + __builtin_amdgcn_exp2f(-gate * LOG2E)) * upv;
                    }
                    u32x2 w; w.x = cvtpk(a[0], a[1]); w.y = cvtpk(a[2], a[3]);
                    *(u32x2*)(act + (size_t)row * DFF + colg) = w;
                    if (m == 0 && fr < 2) { float* p = hb + (size_t)(seg * 4 + fr) * NUP; *(f32x4*)(p + colg) = cg; *(f32x4*)(p + colu) = cu; }
                    if (m == 3 && fr >= 14) { float* p = hb + (size_t)(seg * 4 + 2 + fr - 14) * NUP; *(f32x4*)(p + colg) = cg; *(f32x4*)(p + colu) = cu; }
                }
            }
        }
    }
};

#define MFMA32(a, b, c) __builtin_amdgcn_mfma_f32_32x32x16_bf16((a), (b), (c), 0, 0, 0)
typedef short v4i16_t __attribute__((ext_vector_type(4)));
DI s16x4 vtr(LAS const char* p) { return __builtin_bit_cast(s16x4, __builtin_amdgcn_ds_read_tr16_b64_v4i16((LAS v4i16_t*)p)); }
#define CROWC(i) (((i) & 3) + 8 * ((i) >> 2))

template <int C0, int NC, int NT, int KP>
DI void qk_multi(f32x16 (&S)[NT], LAS const char* krow  , const bf16x8 (&qf)[4], float slope2, int dt0, int hh, float mref) {
    bf16x8 kf[NC][4];
#pragma unroll
    for (int c = 0; c < NC; ++c)
#pragma unroll
        for (int st = 0; st < 4; ++st) kf[c][st] = *(const LAS bf16x8*)(krow + (C0 + c) * 32 * KP + st * 32);
    __builtin_amdgcn_sched_barrier(0);
#pragma unroll
    for (int c = 0; c < NC; ++c) {
        const float base2 = slope2 * (float)(4 * hh - (dt0 - 32 * (C0 + c))) - mref;
#pragma unroll
        for (int i = 0; i < 16; ++i) S[C0 + c][i] = fmaf(slope2, (float)CROWC(i), base2);
    }
    __builtin_amdgcn_s_setprio(1);
#pragma unroll
    for (int st = 0; st < 4; ++st)
#pragma unroll
        for (int c = 0; c < NC; ++c) S[C0 + c] = MFMA32(kf[c][st], qf[st], S[C0 + c]);
    __builtin_amdgcn_s_setprio(0);
}
template <int WIN> DI void mask_chunk(f32x16& S, int dt0, int hh, int lo) {
    const int dh = dt0 - 4 * hh, lo2 = lo - 4 * hh;
#pragma unroll
    for (int i = 0; i < 16; ++i) { const int rel = dh - CROWC(i); if (rel < 0 || rel >= WIN || CROWC(i) < lo2) S[i] = -INFINITY; }
}
constexpr float SM_THR = 8.0f;
template <int NH, int NDB, int VP, bool FIXED_REF = false>
DI void softmax_pv(f32x16 (&S)[NH], float& m, float& l, f32x16 (&O)[NDB], LAS const char* vrow) {
    constexpr int NS = 2 * NH;
    s16x4 vlo[2][NDB], vhi[2][NDB];
#define SPV_LOADV(k) do { _Pragma("unroll") for (int db = 0; db < NDB; ++db) { vlo[(k) & 1][db] = vtr(vrow + (16 * (k)) * VP + 64 * db); vhi[(k) & 1][db] = vtr(vrow + (16 * (k) + 8) * VP + 64 * db); } } while (0)
    SPV_LOADV(0);
    float mx = -INFINITY;
    if (!FIXED_REF) {
#pragma unroll
        for (int h = 0; h < NH; ++h)
#pragma unroll
            for (int i = 0; i < 16; i += 2) mx = fmaxf(fmaxf(mx, S[h][i]), S[h][i + 1]);
        mx = xhalf_max(mx);
    }
    if (!FIXED_REF && __any(mx > SM_THR)) {
        const float dl = fmaxf(mx, 0.f), f = __builtin_amdgcn_exp2f(-dl); m += dl; l *= f;
#pragma unroll
        for (int h = 0; h < NH; ++h)
#pragma unroll
            for (int i = 0; i < 16; ++i) S[h][i] -= dl;
#pragma unroll
        for (int db = 0; db < NDB; ++db) O[db] = O[db] * f;
    }
    float rs0 = 0.f, rs1 = 0.f;
#pragma unroll
    for (int h = 0; h < NH; ++h)
#pragma unroll
        for (int i = 0; i < 16; i += 2) { S[h][i] = __builtin_amdgcn_exp2f(S[h][i]); S[h][i + 1] = __builtin_amdgcn_exp2f(S[h][i + 1]); rs0 += S[h][i]; rs1 += S[h][i + 1]; }
    l += rs0 + rs1;
#pragma unroll
    for (int k = 0; k < NS; ++k) {
        const int h = k >> 1, s = k & 1;
        if (k + 1 < NS) SPV_LOADV(k + 1);
        u32x4 pw; pw.x = cvtpk(S[h][8 * s], S[h][8 * s + 1]); pw.y = cvtpk(S[h][8 * s + 2], S[h][8 * s + 3]); pw.z = cvtpk(S[h][8 * s + 4], S[h][8 * s + 5]); pw.w = cvtpk(S[h][8 * s + 6], S[h][8 * s + 7]);
        const bf16x8 pf = __builtin_bit_cast(bf16x8, pw);
        __builtin_amdgcn_sched_barrier(0);
        __builtin_amdgcn_s_setprio(1);
#pragma unroll
        for (int db = 0; db < NDB; ++db) {
            const s16x4 lo = vlo[k & 1][db], hi = vhi[k & 1][db];
            const bf16x8 vf = (bf16x8){lo[0], lo[1], lo[2], lo[3], hi[0], hi[1], hi[2], hi[3]};
            O[db] = MFMA32(vf, pf, O[db]);
        }
        __builtin_amdgcn_s_setprio(0);
    }
#undef SPV_LOADV
}

constexpr float ALIBI_SKIP_BITS = 64.0f;
DI void diff_attn_phase(LAS unsigned char* lds, const bf16_t* qkv, bf16_t* mix, const float* lamp, const float* subg, const float* qg, const float* kg, float lam_init, unsigned* queue) {
    int tid = threadIdx.x; asm volatile("" : "+v"(tid));
    const int lane = tid & 63, wave = __builtin_amdgcn_readfirstlane(tid >> 6), r = lane & 31, hh = lane >> 5, i16 = lane & 15, blk = (lane >> 4) & 1;
    const int mp = wave & 1, rg = wave >> 1;
    float lam, B2;
    { const float s1 = wave_sum(lamp[lane] * lamp[64 + lane]), s2 = wave_sum(lamp[128 + lane] * lamp[192 + lane]); lam = expf(s1) - expf(s2) + lam_init;
      float gq = fabsf(qg[lane]), gk = fabsf(kg[lane]);
#pragma unroll
      for (int o = 1; o < 64; o <<= 1) { gq = fmaxf(gq, __shfl_xor(gq, o)); gk = fmaxf(gk, __shfl_xor(gk, o)); }
      B2 = 8.0f * LOG2E * gq * gk * 1.01f + 0.5f; }
    const bool fixed_ref = B2 < 40.0f;
    constexpr int KP = 272, VP = 320, KB = 64 * KP, VB = 64 * VP, BUF = KB + VB;
    LAS unsigned* qword = (LAS unsigned*)(lds + 2 * BUF);
    for (;;) {
        if (tid == 0) *qword = __hip_atomic_fetch_add(queue, 1u, __ATOMIC_RELAXED, __HIP_MEMORY_SCOPE_AGENT);
        __syncthreads();
        const int item = (int)*qword;
        if (item >= 1024) break;
        const int qb = 31 - (item >> 5), bh = item & 31, b = bh >> 2, h = bh & 3;
        const float slope2 = exp2f(-2.0f * (float)(h + 1)) * LOG2E;
        const size_t rowbase = (size_t)b * SEQ;
        {
            const int q0 = qb * 128, tq0 = q0 + 32 * rg, t = tq0 + r;
            bf16x8 qf[4];
            { const bf16_t* qp = qkv + (rowbase + t) * AB_IN + h * 128 + mp * 64 + hh * 8;
#pragma unroll
              for (int st = 0; st < 4; ++st) qf[st] = *(const bf16x8*)(qp + st * 16); }
            const int NT = (q0 + 128) / 64;
            const int wk = (int)fminf((2.0f * B2 + ALIBI_SKIP_BITS) / slope2 + 1.0f, 1.0e6f);
            const int tt0 = (q0 - wk) > 0 ? (q0 - wk) / 64 : 0;
            const bf16_t* gk_ = qkv + rowbase * AB_IN + 512 + h * 128;
            const bf16_t* gv_ = qkv + rowbase * AB_IN + 1024 + h * 128;
            u32x4 kreg[2], vreg[2];
#define DA_LOAD(tt) do { _Pragma("unroll") for (int i = 0; i < 2; ++i) { const int c = tid + 512 * i, row = c >> 4, cc = c & 15; \
                kreg[i] = *(const u32x4*)(gk_ + (size_t)((tt) * 64 + row) * AB_IN + cc * 8); vreg[i] = *(const u32x4*)(gv_ + (size_t)((tt) * 64 + row) * AB_IN + cc * 8); } } while (0)
#define DA_STORE(buf) do { _Pragma("unroll") for (int i = 0; i < 2; ++i) { const int c = tid + 512 * i, row = c >> 4, cc = c & 15; \
                *(LAS u32x4*)(lds + (buf) * BUF + row * KP + cc * 16) = kreg[i]; *(LAS u32x4*)(lds + (buf) * BUF + KB + row * VP + cc * 16) = vreg[i]; } } while (0)
            float m = -B2, l = 0.f; f32x16 O[4];
#pragma unroll
            for (int db = 0; db < 4; ++db) O[db] = (f32x16){};
            DA_LOAD(tt0); DA_STORE(tt0 & 1); __syncthreads();
            asm volatile("" : "+v"(qf[0]), "+v"(qf[1]), "+v"(qf[2]), "+v"(qf[3]));
            for (int tt = tt0; tt < NT; ++tt) {
                const int buf = tt & 1, kv0 = tt * 64;
                if (tt + 1 < NT) DA_LOAD(tt + 1);
                if (kv0 <= tq0 + 31) {
                    LAS const char* kb = (LAS const char*)lds + buf * BUF + r * KP + hh * 16 + mp * 128;
                    LAS const char* vb = (LAS const char*)lds + buf * BUF + KB + (4 * hh + (i16 >> 2)) * VP + 32 * blk + 8 * (i16 & 3);
                    const int dt0 = t - kv0;
                    f32x16 S[2];
                    qk_multi<0, 2, 2, KP>(S, kb, qf, slope2, dt0, hh, m);
                    if (kv0 + 63 > tq0) { mask_chunk<(1 << 30)>(S[0], dt0, hh, -(1 << 30)); mask_chunk<(1 << 30)>(S[1], dt0 - 32, hh, -(1 << 30)); }
                    if (fixed_ref) softmax_pv<2, 4, VP, true>(S, m, l, O, vb); else softmax_pv<2, 4, VP, false>(S, m, l, O, vb);
                }
                if (tt + 1 < NT) DA_STORE(buf ^ 1);
                __syncthreads();
            }
#undef DA_LOAD
#undef DA_STORE
            const float lt = xhalf_sum(l);
            const float inv = (mp ? lam : 1.0f) / lt;
            LAS float* X = (LAS float*)lds + rg * 4096;
            if (mp) {
#pragma unroll
                for (int db = 0; db < 4; ++db)
#pragma unroll
                    for (int i = 0; i < 16; ++i) X[(db * 16 + i) * 64 + lane] = O[db][i] * inv;
            }
            __syncthreads();
            if (!mp) {
                float ss = 0.f;
#pragma unroll
                for (int db = 0; db < 4; ++db)
#pragma unroll
                    for (int i = 0; i < 16; ++i) { const float a = O[db][i] * inv - X[(db * 16 + i) * 64 + lane]; O[db][i] = a; ss += a * a; }
                ss = xhalf_sum(ss);
                const float rn = rsqrtf(ss * (1.0f / 128.0f) + EPS) * (1.0f - lam_init);
                bf16_t* op = mix + (rowbase + t) * DM + h * 128 + 4 * hh;
#pragma unroll
                for (int db = 0; db < 4; ++db)
#pragma unroll
                    for (int g4 = 0; g4 < 4; ++g4) {
                        const int d0 = 32 * db + 8 * g4;
                        const f32x4 sg = *(const f32x4*)(subg + d0 + 4 * hh);
                        u32x2 w; w.x = cvtpk(O[db][4 * g4] * rn * sg[0], O[db][4 * g4 + 1] * rn * sg[1]); w.y = cvtpk(O[db][4 * g4 + 2] * rn * sg[2], O[db][4 * g4 + 3] * rn * sg[3]);
                        *(u32x2*)(op + d0) = w;
                    }
            }
            __syncthreads();
        }
    }
}
template <int W> struct PoolRegs { u32x4 v[W + 7]; };
template <int W> DI void pool_load(PoolRegs<W>& R, const bf16_t* up, int tpos0) {
#pragma unroll
    for (int j = 0; j < W + 7; ++j) { R.v[j] = (u32x4){0u, 0u, 0u, 0u}; if (tpos0 + j - (W - 1) >= 0) R.v[j] = *(const u32x4*)(up + (ptrdiff_t)(j - (W - 1)) * AB_IN); }
}
template <int W> DI void pool_compute(const PoolRegs<W>& R, bf16_t* op, int tpos0) {
    float sum[8];
#pragma unroll
    for (int c = 0; c < 8; ++c) sum[c] = 0.f;
#define PL_ACC(SGN, X) do { sum[0] += SGN bf_lo((X).x); sum[1] += SGN bf_hi((X).x); sum[2] += SGN bf_lo((X).y); sum[3] += SGN bf_hi((X).y); \
                            sum[4] += SGN bf_lo((X).z); sum[5] += SGN bf_hi((X).z); sum[6] += SGN bf_lo((X).w); sum[7] += SGN bf_hi((X).w); } while (0)
#pragma unroll
    for (int j = 0; j < W - 1; ++j) PL_ACC(+, R.v[j]);
#pragma unroll
    for (int r = 0; r < 8; ++r) {
        const u32x4 own = R.v[W - 1 + r];
        PL_ACC(+, own);
        const int cnt = (tpos0 + r + 1 < W) ? tpos0 + r + 1 : W;
        const float rn = 1.0f / (float)cnt;
        u32x4 o; o.x = cvtpk(sum[0] * rn - bf_lo(own.x), sum[1] * rn - bf_hi(own.x)); o.y = cvtpk(sum[2] * rn - bf_lo(own.y), sum[3] * rn - bf_hi(own.y));
        o.z = cvtpk(sum[4] * rn - bf_lo(own.z), sum[5] * rn - bf_hi(own.z)); o.w = cvtpk(sum[6] * rn - bf_lo(own.w), sum[7] * rn - bf_hi(own.w));
        *(u32x4*)(op + (size_t)r * DM) = o;
        PL_ACC(-, R.v[r]);
    }
#undef PL_ACC
}
DI void pool_phase(const bf16_t* qkv, bf16_t* mix, int G, int bid) {
    int tid = threadIdx.x; asm volatile("" : "+v"(tid));
    const int lane = tid & 63, wave = __builtin_amdgcn_readfirstlane(tid >> 6);
    for (int p = bid * 8 + wave; p < 2 * (MTOK / 32); p += G * 8) {
        const int row0 = (p >> 1) * 32 + (lane >> 4) * 8, tpos0 = row0 & (SEQ - 1), c8 = (lane & 15) * 8;
        const bf16_t* ub = qkv + (size_t)row0 * AB_IN + 1536 + c8; bf16_t* ob = mix + (size_t)row0 * DM + 512 + c8;
        if ((p & 1) == 0) { PoolRegs<2> a; PoolRegs<16> b; pool_load(a, ub, tpos0); pool_load(b, ub + 384, tpos0); pool_compute(a, ob, tpos0); pool_compute(b, ob + 384, tpos0); }
        else              { PoolRegs<4> a; PoolRegs<8> b;  pool_load(a, ub + 128, tpos0); pool_load(b, ub + 256, tpos0); pool_compute(a, ob + 128, tpos0); pool_compute(b, ob + 256, tpos0); }
    }
}
DI void swa_phase(LAS unsigned char* lds, const bf16_t* qkv, bf16_t* mix, const float* sinks, const float* qg, const float* kg, int G, int bid) {
    int tid = threadIdx.x; asm volatile("" : "+v"(tid));
    const int lane = tid & 63, wave = __builtin_amdgcn_readfirstlane(tid >> 6), r = lane & 31, hh = lane >> 5, i16 = lane & 15, blk = (lane >> 4) & 1;
    constexpr int KP = 144, VP = 192, KB = 256 * KP;
    float B2;
    { float gq = fabsf(qg[lane]), gk = fabsf(kg[lane]);
#pragma unroll
      for (int o = 1; o < 64; o <<= 1) { gq = fmaxf(gq, __shfl_xor(gq, o)); gk = fmaxf(gk, __shfl_xor(gk, o)); }
      B2 = 8.0f * LOG2E * gq * gk * 1.01f + 0.5f; }
    for (int unit = bid; unit < 512; unit += G) {
        const int qb = unit & 31, kvh = (unit >> 5) & 1, b = unit >> 6;
        const int t0 = qb * 128; const size_t rowbase = (size_t)b * SEQ;
#pragma unroll
        for (int i = 0; i < 4; ++i) {
            const int c = tid + 512 * i, row = c >> 3, cc = c & 7, kvpos = t0 - 128 + row;
            u32x4 kx = (u32x4){0u, 0u, 0u, 0u}, vx = kx;
            if (kvpos >= 0) { const bf16_t* p = qkv + (rowbase + kvpos) * C_IN + 1024 + kvh * 64 + cc * 8; kx = *(const u32x4*)p; vx = *(const u32x4*)(p + 128); }
            *(LAS u32x4*)(lds + row * KP + cc * 16) = kx; *(LAS u32x4*)(lds + KB + row * VP + cc * 16) = vx;
        }
        __syncthreads();
        const int head = kvh * 8 + wave;
        const float slope2 = exp2f(-0.5f * (float)(head + 1)) * LOG2E, sink2 = sinks[head] * LOG2E;
        const bool fixed_ref = B2 < 40.0f && fabsf(sink2) < 40.0f;
        bf16x8 qf[4], qn[4];
        { const bf16_t* qp = qkv + (rowbase + t0 + r) * C_IN + head * 64 + hh * 8;
#pragma unroll
          for (int st = 0; st < 4; ++st) qf[st] = *(const bf16x8*)(qp + st * 16); }
#pragma unroll 1
        for (int j_ = 0; j_ < 4; ++j_) {
            int j = j_; asm volatile("" : "+s"(j));
            const int tq0 = t0 + 32 * j, t = tq0 + r;
            { const bf16_t* qp = qkv + (rowbase + (j < 3 ? t + 32 : t)) * C_IN + head * 64 + hh * 8;
#pragma unroll
              for (int st = 0; st < 4; ++st) qn[st] = *(const bf16x8*)(qp + st * 16); }
            asm volatile("" : "+v"(qf[0]), "+v"(qf[1]), "+v"(qf[2]), "+v"(qf[3]));
            float m = fixed_ref ? -B2 : sink2, l = hh == 0 ? (fixed_ref ? __builtin_amdgcn_exp2f(sink2 + B2) : 1.0f) : 0.0f; f32x16 O[2]; O[0] = (f32x16){}; O[1] = (f32x16){};
            {
                const int kvc0 = t0 - 128 + 32 * j;
                LAS const char* kb = (LAS const char*)lds + (32 * j + r) * KP + hh * 16;
                LAS const char* vb = (LAS const char*)lds + KB + (32 * j + 4 * hh + (i16 >> 2)) * VP + 32 * blk + 8 * (i16 & 3);
                int dt0 = t - kvc0; asm volatile("" : "+v"(dt0));
                f32x16 S[5];
                qk_multi<0, 3, 5, KP>(S, kb, qf, slope2, dt0, hh, m); qk_multi<3, 2, 5, KP>(S, kb, qf, slope2, dt0, hh, m);
                mask_chunk<128>(S[0], dt0, hh, -kvc0);
                mask_chunk<128>(S[4], dt0 - 128, hh, -kvc0 - 128);
                if (kvc0 < 0) {
#pragma unroll
                    for (int c = 1; c < 4; ++c) mask_chunk<128>(S[c], dt0 - 32 * c, hh, -kvc0 - 32 * c);
                }
                if (fixed_ref) softmax_pv<5, 2, VP, true>(S, m, l, O, vb); else softmax_pv<5, 2, VP, false>(S, m, l, O, vb);
            }
            const float inv = 1.0f / xhalf_sum(l);
            bf16_t* op = mix + (rowbase + t) * DM + head * 64 + 4 * hh;
#pragma unroll
            for (int db = 0; db < 2; ++db)
#pragma unroll
                for (int g4 = 0; g4 < 4; ++g4) {
                    u32x2 w; w.x = cvtpk(O[db][4 * g4] * inv, O[db][4 * g4 + 1] * inv); w.y = cvtpk(O[db][4 * g4 + 2] * inv, O[db][4 * g4 + 3] * inv);
                    *(u32x2*)(op + 32 * db + 8 * g4) = w;
                }
#pragma unroll
            for (int st = 0; st < 4; ++st) qf[st] = qn[st];
        }
        __syncthreads();
    }
}
DI void fixup_phase(const float* hb, const float* cw, const float* cb, bf16_t* act, int G, int bid) {
    int tid = threadIdx.x; asm volatile("" : "+v"(tid));
    const int nth = G * 512;
    for (int idx = bid * 512 + tid; idx < 512 * (DFF / 4); idx += nth) {
        const int f4 = idx % (DFF / 4), seg = idx / (DFF / 4), ff = 4 * f4;
        if ((seg & 63) == 0) continue;
        const float* a0 = hb + (size_t)(seg * 4) * NUP + ff;
        const float* a1 = a0 + NUP;
        const float* p2 = hb + (size_t)((seg - 1) * 4 + 2) * NUP + ff;
        const float* p3 = p2 + NUP;
        const f32x4 g0 = *(const f32x4*)a0, g1 = *(const f32x4*)a1, gp2 = *(const f32x4*)p2, gp3 = *(const f32x4*)p3;
        const f32x4 u0 = *(const f32x4*)(a0 + DFF), u1 = *(const f32x4*)(a1 + DFF), up2 = *(const f32x4*)(p2 + DFF), up3 = *(const f32x4*)(p3 + DFF);
        const f32x4 wg0 = *(const f32x4*)(cw + ff), wg1 = *(const f32x4*)(cw + NUP + ff), wg2 = *(const f32x4*)(cw + 2 * NUP + ff), bg = *(const f32x4*)(cb + ff);
        const f32x4 wu0 = *(const f32x4*)(cw + DFF + ff), wu1 = *(const f32x4*)(cw + NUP + DFF + ff), wu2 = *(const f32x4*)(cw + 2 * NUP + DFF + ff), bu = *(const f32x4*)(cb + DFF + ff);
        const f32x4 gate0 = bg + wg0 * gp2 + wg1 * gp3 + wg2 * g0, upv0 = bu + wu0 * up2 + wu1 * up3 + wu2 * u0;
        const f32x4 gate1 = bg + wg0 * gp3 + wg1 * g0 + wg2 * g1, upv1 = bu + wu0 * up3 + wu1 * u0 + wu2 * u1;
        float a[4], b[4];
#pragma unroll
        for (int i = 0; i < 4; ++i) {
            a[i] = gate0[i] * __builtin_amdgcn_rcpf(1.0f + __builtin_amdgcn_exp2f(-gate0[i] * LOG2E)) * upv0[i];
            b[i] = gate1[i] * __builtin_amdgcn_rcpf(1.0f + __builtin_amdgcn_exp2f(-gate1[i] * LOG2E)) * upv1[i];
        }
        u32x2 w0, w1; w0.x = cvtpk(a[0], a[1]); w0.y = cvtpk(a[2], a[3]); w1.x = cvtpk(b[0], b[1]); w1.y = cvtpk(b[2], b[3]);
        bf16_t* op = act + (size_t)(seg * 64) * DFF + ff;
        *(u32x2*)op = w0; *(u32x2*)(op + DFF) = w1;
    }
}

DI void transpose_item64(const float* W, int ldw, const float* gain, bf16_t* WT, int ldk, int k0, int n0, int wtA, int wtB, LAS float* scr, int lane) {
    const int c4 = (lane & 15) * 4, rl = lane >> 4;
    f32x4 v[16];
#pragma unroll
    for (int i = 0; i < 16; ++i) v[i] = *(const f32x4*)(W + (size_t)(k0 + 4 * i + rl) * ldw + n0 + c4);
    if (gain) {
#pragma unroll
        for (int i = 0; i < 16; ++i) v[i] = v[i] * gain[k0 + 4 * i + rl];
    }
#pragma unroll
    for (int i = 0; i < 16; ++i) *(LAS f32x4*)(scr + (4 * i + rl) * 68 + c4) = v[i];
    asm volatile("s_waitcnt lgkmcnt(0)" ::: "memory");
    bf16_t* dst = WT + (size_t)((lane < 32 ? wtA : wtB - 32) + lane) * ldk + k0;
#pragma unroll
    for (int c = 0; c < 8; ++c) { const LAS float* sp = scr + (8 * c) * 68 + lane;
        u32x4 o; o.x = cvtpk(sp[0 * 68], sp[1 * 68]); o.y = cvtpk(sp[2 * 68], sp[3 * 68]); o.z = cvtpk(sp[4 * 68], sp[5 * 68]); o.w = cvtpk(sp[6 * 68], sp[7 * 68]);
        *(u32x4*)(dst + 8 * c) = o; }
    asm volatile("s_waitcnt lgkmcnt(0)" ::: "memory");
}
DI void pairmap(int kind, int p, int& n0, int& wtA, int& wtB) {
    if (kind == 1) { const int pn = p >> 2, wc = p & 3; n0 = 256 * pn + 64 * wc; wtA = 32 * (8 * pn + wc); wtB = wtA + 128; }
    else if (kind == 2) { const int pn = p >> 2, bj = (p >> 1) & 1, w2 = p & 1; n0 = bj * DFF + 128 * pn + 64 * w2; wtA = 32 * (8 * pn + 4 * bj + 2 * w2); wtB = wtA + 32; }
    else { n0 = 64 * p; wtA = 64 * p; wtB = wtA + 32; }
}
#define XB_TMO      128
#define XB_XCNT(j)  (256  + 64 * (j))
#define XB_XSUB(j)  (1280 + 64 * (j))
#define XB_XGEN(j)  (2304 + 64 * (j))
#define XB_TOP      3328
#define XB_TOPGEN   3392
#define XCD_BAR_WORDS 3456
#define XB_SPIN_CAP (1u << 18)
DI unsigned xb_ld(unsigned* p)              { return __hip_atomic_load(p, __ATOMIC_RELAXED, __HIP_MEMORY_SCOPE_AGENT); }
DI unsigned xb_add(unsigned* p, unsigned v) { return __hip_atomic_fetch_add(p, v, __ATOMIC_RELAXED, __HIP_MEMORY_SCOPE_AGENT); }
DI unsigned xb_xcc_id() { return (unsigned)__builtin_amdgcn_s_getreg((3 << 11) | 20) & 0xFu; }
#define XB_SPIN(cond, bar) do { unsigned _sp = 0; while (cond) { __builtin_amdgcn_s_sleep(1); \
    if ((++_sp & 255u) == 0u) { if (xb_ld(&(bar)[XB_TMO])) break; if (_sp > XB_SPIN_CAP) { atomicAdd(&(bar)[XB_TMO], 1u); break; } } } } while (0)
struct XcdBarrier { unsigned* bar; unsigned x; volatile LAS unsigned* st; };
DI XcdBarrier xcd_barrier_post(unsigned* bar, volatile LAS unsigned* st) {
    XcdBarrier b; b.bar = bar; b.x = xb_xcc_id(); b.st = st;
    if (threadIdx.x == 0) (void)xb_add(&bar[XB_XCNT(b.x)], 1u);
    return b;
}
DI void xcd_barrier_complete(unsigned* bar, unsigned x, unsigned& nloc, unsigned& nx) {
    const unsigned G = gridDim.x * gridDim.y * gridDim.z;
    unsigned sum, cnt, mine, sp = 0u;
    for (;;) {
        sum = 0u; cnt = 0u; mine = 0u;
#pragma unroll
        for (unsigned j = 0; j < 16; ++j) { const unsigned c = xb_ld(&bar[XB_XCNT(j)]); sum += c; cnt += (c > 0u) ? 1u : 0u; mine = (j == x) ? c : mine; }
        if (sum == G) break;
        __builtin_amdgcn_s_sleep(1);
        if ((++sp & 255u) == 0u) { if (xb_ld(&bar[XB_TMO])) break; if (sp > XB_SPIN_CAP) { atomicAdd(&bar[XB_TMO], 1u); break; } }
    }
    nloc = mine > 0u ? mine : 1u; nx = cnt > 0u ? cnt : 1u;
}
DI void xcd_barrier(const XcdBarrier& b) {
    asm volatile("s_waitcnt vmcnt(0)" ::: "memory");
    __syncthreads();
    if (threadIdx.x == 0) {
        unsigned* bar = b.bar;
        __builtin_amdgcn_s_waitcnt(0);
        unsigned nloc = b.st[0], nx = b.st[1];
        if (nloc == 0u) { xcd_barrier_complete(bar, b.x, nloc, nx); b.st[0] = nloc; b.st[1] = nx; }
        const unsigned old = xb_add(&bar[XB_XSUB(b.x)], 1u);
        const unsigned gen = old / nloc;
        if (old + 1u == (gen + 1u) * nloc) {
            __builtin_amdgcn_fence(__ATOMIC_RELEASE, "agent");
            asm volatile("s_waitcnt vmcnt(0)" ::: "memory");
            const unsigned og = xb_add(&bar[XB_TOP], 1u);
            const unsigned tg = og / nx;
            if (og + 1u == (tg + 1u) * nx) xb_add(&bar[XB_TOPGEN], 1u);
            else XB_SPIN(xb_ld(&bar[XB_TOPGEN]) == tg, bar);
            __builtin_amdgcn_fence(__ATOMIC_ACQUIRE, "agent");
            xb_add(&bar[XB_XGEN(b.x)], 1u);
            asm volatile("s_waitcnt vmcnt(0)" ::: "memory");
        } else {
            XB_SPIN(xb_ld(&bar[XB_XGEN(b.x)]) == gen, bar);
            __builtin_amdgcn_fence(__ATOMIC_ACQUIRE, "agent");
            asm volatile("s_waitcnt vmcnt(0)" ::: "memory");
        }
    }
    __syncthreads();
}
struct Args {
    const float* in[21]; float* out; unsigned char* ws; int ph_lo, ph_hi;
};
constexpr int NPHASE = 1 + 6 * DEPTH;
constexpr int LDS_BYTES = 147456;

DI void prologue(const Args& A, LAS unsigned char* lds, int G, int bid) {
    const int tid = threadIdx.x, lane = tid & 63, wave = tid >> 6;
    unsigned char* ws = A.ws;
    LAS float* scr = (LAS float*)(lds + wave * 17408);
    const int gw = bid * 8 + wave, NGW = G * 8;
    constexpr int I_ABIN = 16 * 32, I_ABOUT = 8 * 16, I_CIN = 16 * 20, I_COUT = 16 * 16, I_UP = 16 * 88, I_DOWN = 44 * 16;
    constexpr int NITEMS = 2 * I_ABIN + 2 * I_ABOUT + 2 * I_CIN + 2 * I_COUT + 4 * I_UP + 4 * I_DOWN;
    for (int it = gw; it < NITEMS; it += NGW) {
        int rI = it, n0, wtA, wtB;
        if (rI < 2 * I_ABIN) { const int e = rI / I_ABIN, q = rI % I_ABIN, kb = q / 32; pairmap(1, q % 32, n0, wtA, wtB);
            transpose_item64(A.in[2] + (size_t)e * DM * AB_IN, AB_IN, A.in[1] + e * DM, (bf16_t*)(ws + WS_W_ABIN) + (size_t)e * AB_IN * DM, DM, kb * 64, n0, wtA, wtB, scr, lane); continue; }
        rI -= 2 * I_ABIN;
        if (rI < 2 * I_ABOUT) { const int e = rI / I_ABOUT, q = rI % I_ABOUT, kb = q / 16; pairmap(0, q % 16, n0, wtA, wtB);
            transpose_item64(A.in[9] + (size_t)e * DM * DM, DM, nullptr, (bf16_t*)(ws + WS_W_ABOUT) + (size_t)e * DM * DM, DM, kb * 64, n0, wtA, wtB, scr, lane); continue; }
        rI -= 2 * I_ABOUT;
        if (rI < 2 * I_CIN) { const int e = rI / I_CIN, q = rI % I_CIN, kb = q / 20; pairmap(1, q % 20, n0, wtA, wtB);
            transpose_item64(A.in[11] + (size_t)e * DM * C_IN, C_IN, A.in[10] + e * DM, (bf16_t*)(ws + WS_W_CIN) + (size_t)e * C_IN * DM, DM, kb * 64, n0, wtA, wtB, scr, lane); continue; }
        rI -= 2 * I_CIN;
        if (rI < 2 * I_COUT) { const int e = rI / I_COUT, q = rI % I_COUT, kb = q / 16; pairmap(0, q % 16, n0, wtA, wtB);
            transpose_item64(A.in[15] + (size_t)e * DM * DM, DM, nullptr, (bf16_t*)(ws + WS_W_COUT) + (size_t)e * DM * DM, DM, kb * 64, n0, wtA, wtB, scr, lane); continue; }
        rI -= 2 * I_COUT;
        if (rI < 4 * I_UP) { const int e = rI / I_UP, q = rI % I_UP, kb = q / 88; pairmap(2, q % 88, n0, wtA, wtB);
            transpose_item64(A.in[17] + (size_t)e * DM * NUP, NUP, A.in[16] + e * DM, (bf16_t*)(ws + WS_W_UP) + (size_t)e * NUP * DM, DM, kb * 64, n0, wtA, wtB, scr, lane); continue; }
        rI -= 4 * I_UP;
        { const int e = rI / I_DOWN, q = rI % I_DOWN, kb = q / 16; pairmap(0, q % 16, n0, wtA, wtB);
            transpose_item64(A.in[20] + (size_t)e * DFF * DM, DM, nullptr, (bf16_t*)(ws + WS_W_DOWN) + (size_t)e * DM * DFF, DFF, kb * 64, n0, wtA, wtB, scr, lane); }
    }
    const int nth = G * 512;
    for (int it = gw; it < 2 * 4 * 16 * 16; it += NGW) {
        const int n = (it & 15) * 64 + lane, c0 = ((it >> 4) & 15) * 8, g = (it >> 8) & 3, e = it >> 10;
        const float* wg = A.in[7] + ((size_t)(e * 4 + g) * 128 + c0) * 128;
        const float* sc = A.in[8] + e * 512 + 128 * g;
        const float* wo = A.in[9] + (size_t)e * DM * DM + (size_t)(512 + 128 * g) * DM + n;
        float acc[8];
#pragma unroll
        for (int j = 0; j < 8; ++j) acc[j] = 0.f;
        for (int d0 = 0; d0 < 128; d0 += 16) {
            float w[16];
#pragma unroll
            for (int dd = 0; dd < 16; ++dd) w[dd] = wo[(size_t)(d0 + dd) * DM];
#pragma unroll
            for (int dd = 0; dd < 16; ++dd) {
                const float ws_ = w[dd] * sc[d0 + dd];
#pragma unroll
                for (int j = 0; j < 8; ++j) acc[j] += wg[j * 128 + d0 + dd] * ws_;
            }
        }
        u32x4 o; o.x = cvtpk(acc[0], acc[1]); o.y = cvtpk(acc[2], acc[3]); o.z = cvtpk(acc[4], acc[5]); o.w = cvtpk(acc[6], acc[7]);
        *(u32x4*)((bf16_t*)(ws + WS_W_ABOUT) + (size_t)e * DM * DM + (size_t)n * DM + 512 + 128 * g + c0) = o;
    }
    float* rowss = (float*)(ws + WS_ROWSS);
    bf16_t* xb = (bf16_t*)(ws + WS_XB);
    for (int mrow = gw; mrow < MTOK; mrow += 2 * NGW) {
        const bool has2 = mrow + NGW < MTOK; const int mrow2 = has2 ? mrow + NGW : mrow;
        const f32x4* xr0 = (const f32x4*)(A.in[0] + (size_t)mrow * DM) + lane;
        const f32x4* xr1 = (const f32x4*)(A.in[0] + (size_t)mrow2 * DM) + lane;
        f32x4 v0[4], v1[4];
#pragma unroll
        for (int j = 0; j < 4; ++j) { v0[j] = xr0[64 * j]; v1[j] = xr1[64 * j]; }
        u32x2* o0 = (u32x2*)(xb + (size_t)mrow * DM) + lane; u32x2* o1 = (u32x2*)(xb + (size_t)mrow2 * DM) + lane;
        float s0 = 0.f, s1 = 0.f;
#pragma unroll
        for (int j = 0; j < 4; ++j) {
            s0 += (v0[j][0] * v0[j][0] + v0[j][1] * v0[j][1]) + (v0[j][2] * v0[j][2] + v0[j][3] * v0[j][3]);
            s1 += (v1[j][0] * v1[j][0] + v1[j][1] * v1[j][1]) + (v1[j][2] * v1[j][2] + v1[j][3] * v1[j][3]);
            u32x2 w; w.x = cvtpk(v0[j][0], v0[j][1]); w.y = cvtpk(v0[j][2], v0[j][3]); o0[64 * j] = w;
            w.x = cvtpk(v1[j][0], v1[j][1]); w.y = cvtpk(v1[j][2], v1[j][3]); if (has2) o1[64 * j] = w;
        }
        s0 = wave_sum(s0); s1 = wave_sum(s1);
        if (lane < 16) { rowss[(size_t)mrow * 16 + lane] = lane == 0 ? s0 : 0.f; if (has2) rowss[(size_t)mrow2 * 16 + lane] = lane == 0 ? s1 : 0.f; }
    }
}

__global__ void __launch_bounds__(512) fwd_megakernel(Args A) {
    extern __shared__ __attribute__((aligned(16))) unsigned char lds_raw[];
    LAS unsigned char* lds = (LAS unsigned char*)lds_raw;
    cg::grid_group grid = cg::this_grid();
    const int G = gridDim.x, bid = blockIdx.x;
    unsigned char* ws = A.ws;
    float* rowss = (float*)(ws + WS_ROWSS);
    bf16_t* xb = (bf16_t*)(ws + WS_XB);
    bf16_t* qkv = (bf16_t*)(ws + WS_QKV);
    bf16_t* mix = (bf16_t*)(ws + WS_MIX);
    bf16_t* act = (bf16_t*)(ws + WS_ACT);
    float* hb = (float*)(ws + WS_HB);
    const int lo = A.ph_lo, hi = A.ph_hi;
#define IN(k) (lo <= (k) && (k) < hi)
    volatile LAS unsigned* bst = (volatile LAS unsigned*)(lds + LDS_BYTES - 64);
    if (threadIdx.x < 2) bst[threadIdx.x] = 0u;
    __syncthreads();
    const XcdBarrier xbar = xcd_barrier_post((unsigned*)(ws + WS_CTL) + 1024, bst);
    if (A.ph_hi < 0) grid.sync();
#define SEAM(k) do { if (IN(k) && IN((k) + 1)) xcd_barrier(xbar); } while (0)
    if (IN(0)) { prologue(A, lds, G, bid); __syncthreads(); }
    SEAM(0);
    for (int layer_ = 0; layer_ < DEPTH; ++layer_) {
        int layer = layer_; asm volatile("" : "+s"(layer));
        const int pb = 1 + 6 * layer, e = layer >> 1;
        const bool even = (layer & 1) == 0;
        if (IN(pb)) {
            pg8::StaticOrder S;
            if (even) {
                pg8::Gemm g{xb, (const bf16_t*)(ws + WS_W_ABIN) + (size_t)e * AB_IN * DM, MTOK, AB_IN, DM}; S.init(MTOK, AB_IN, G, bid);
                EpiQKV E{rowss + (size_t)(2 * layer) * MTOK * 16, A.in[3] + e * 64, A.in[4] + e * 64, qkv, AB_IN, 8, 16, (LAS float*)(lds + RTAB_OFF)};
                pg8::gemm_phase<EpiQKV>(lds, g, S, E);
            } else {
                pg8::Gemm g{xb, (const bf16_t*)(ws + WS_W_CIN) + (size_t)e * C_IN * DM, MTOK, C_IN, DM}; S.init(MTOK, C_IN, G, bid);
                EpiQKV E{rowss + (size_t)(2 * layer) * MTOK * 16, A.in[12] + e * 64, A.in[13] + e * 64, qkv, C_IN, 16, 18, (LAS float*)(lds + RTAB_OFF)};
                pg8::gemm_phase<EpiQKV>(lds, g, S, E);
            }
        }
        SEAM(pb);
        if (IN(pb + 1)) {
            if (even) {
                pool_phase(qkv, mix, G, bid);
                diff_attn_phase(lds, qkv, mix, A.in[5] + e * 256, A.in[6] + e * 128, A.in[3] + e * 64, A.in[4] + e * 64, 0.8f - 0.6f * expf(-0.3f * (float)layer), (unsigned*)(ws + WS_CTL) + 64 + 64 * e);
            } else {
                swa_phase(lds, qkv, mix, A.in[14] + e * 16, A.in[12] + e * 64, A.in[13] + e * 64, G, bid);
            }
        }
        SEAM(pb + 1);
        if (IN(pb + 2)) {
            pg8::StaticOrder S; S.init(MTOK, DM, G, bid);
            pg8::Gemm g{mix, (const bf16_t*)(ws + (even ? WS_W_ABOUT : WS_W_COUT)) + (size_t)e * DM * DM, MTOK, DM, DM};
            EpiRes E{layer == 0 ? A.in[0] : nullptr, xb, nullptr, rowss + (size_t)(2 * layer + 1) * MTOK * 16};
            pg8::gemm_phase<EpiRes>(lds, g, S, E);
        }
        SEAM(pb + 2);
        if (IN(pb + 3)) {
            pg8::StaticOrder S; S.init(MTOK, NUP, G, bid);
            pg8::Gemm g{xb, (const bf16_t*)(ws + WS_W_UP) + (size_t)layer * NUP * DM, MTOK, NUP, DM};
            EpiUp E{rowss + (size_t)(2 * layer + 1) * MTOK * 16, A.in[18] + (size_t)layer * 3 * NUP, A.in[19] + (size_t)layer * NUP, act, hb, (LAS float*)(lds + RTAB_OFF)};
            pg8::gemm_phase<EpiUp>(lds, g, S, E);
        }
        SEAM(pb + 3);
        if (IN(pb + 4)) fixup_phase(hb, A.in[18] + (size_t)layer * 3 * NUP, A.in[19] + (size_t)layer * NUP, act, G, bid);
        SEAM(pb + 4);
        if (IN(pb + 5)) {
            pg8::StaticOrder S; S.init(MTOK, DM, G, bid);
            pg8::Gemm g{act, (const bf16_t*)(ws + WS_W_DOWN) + (size_t)layer * DM * DFF, MTOK, DM, DFF};
            const bool lastl = layer == DEPTH - 1;
            EpiRes E{nullptr, xb, lastl ? A.out : nullptr, lastl ? nullptr : rowss + (size_t)(2 * layer + 2) * MTOK * 16};
            pg8::gemm_phase<EpiRes>(lds, g, S, E);
        }
        SEAM(pb + 5);
    }
#undef IN
#undef SEAM
}

extern "C" void kernel_launch(void* const* d_in, const int* in_sizes, int n_in, void* d_out, int out_size, void* d_ws, size_t ws_size, hipStream_t stream) {
    static int grid = 0;
    if (grid == 0) {
        if (n_in != 21 || out_size != MTOK * DM || ws_size < WS_END) { fprintf(stderr, "kernel_launch: unexpected shapes (n_in %d out %d ws %zu)\n", n_in, out_size, ws_size); grid = -1; return; }
        int dev = 0, cus = 0, per_cu = 0;
        hipGetDevice(&dev);
        hipDeviceGetAttribute(&cus, hipDeviceAttributeMultiprocessorCount, dev);
        hipFuncSetAttribute((const void*)fwd_megakernel, hipFuncAttributeMaxDynamicSharedMemorySize, LDS_BYTES);
        hipOccupancyMaxActiveBlocksPerMultiprocessor(&per_cu, (const void*)fwd_megakernel, 512, LDS_BYTES);
        if (per_cu < 1) per_cu = 1;
        grid = cus * per_cu;
        (void)hipGetLastError();
    }
    if (grid < 0) return;
    (void)hipMemsetAsync((char*)d_ws + WS_CTL, 0, 32768, stream);
    Args a{};
    for (int i = 0; i < 21; ++i) a.in[i] = (const float*)d_in[i];
    a.out = (float*)d_out; a.ws = (unsigned char*)d_ws; a.ph_lo = 0; a.ph_hi = NPHASE;
    void* args[] = {&a};
    hipError_t e = hipLaunchCooperativeKernel((const void*)fwd_megakernel, dim3(grid), dim3(512), args, LDS_BYTES, stream);
    if (e != hipSuccess) fprintf(stderr, "cooperative launch failed: %s (grid %d)\n", hipGetErrorString(e), grid);
}
```
